# Optimizing an MI355X kernel written in HIP

```python
import jax, jax.numpy as jnp
from jax import lax
import numpy as np

D_MODEL = 1024
BATCH = 4
SEQ = 8192
DEPTH = 2

CHUNK = 64
Q_BLOCK = 128
HEAD_DIM = 64
D_MIX = D_MODEL
A_HEADS = 6
A_LEFT_CHUNKS = 8
A_REL_MAX = 128
A_NUM_REL = CHUNK + A_REL_MAX
B_HEADS = 5
IDX_HEADS = 8
IDX_DIM = 32
TOPK_MAX = 256
C_HEADS = 5
C_Q_RANK = 384
C_KV_RANK = 256
C_NOPE = 64
C_ROPE = 32
C_V = 64
D_FF = 2816
ROPE_THETA = 10000.0
EPS = 1e-6
NEG = -1e30

A_W = A_HEADS * HEAD_DIM
B_W = B_HEADS * HEAD_DIM
C_W = C_HEADS * C_V
IN_SIZES = (A_W, A_W, A_W, B_W, B_W, B_W, IDX_HEADS * IDX_DIM, IDX_DIM, IDX_HEADS,
            C_Q_RANK, C_KV_RANK, C_ROPE)
D_IN = 3 * A_W + 3 * B_W + IDX_HEADS * IDX_DIM + IDX_DIM + IDX_HEADS + C_Q_RANK + C_KV_RANK + C_ROPE

kernel_name = "hybrid_streaming_chunkattn_dsa_mla_macaron"


def rmsnorm(x, g):
    x32 = x.astype(jnp.float32)
    y = x32 * lax.rsqrt(jnp.mean(x32 * x32, axis=-1, keepdims=True) + EPS)
    return (y * g.astype(jnp.float32)).astype(x.dtype)


def rope(x, pos):
    d = x.shape[-1]
    inv = ROPE_THETA ** (-jnp.arange(0, d, 2, dtype=jnp.float32) / d)
    ang = pos.astype(jnp.float32)[:, None] * inv[None, :]
    cos = jnp.cos(ang)[:, None, :]
    sin = jnp.sin(ang)[:, None, :]
    x32 = x.astype(jnp.float32)
    x1, x2 = x32[..., : d // 2], x32[..., d // 2:]
    return jnp.concatenate([x1 * cos - x2 * sin, x1 * sin + x2 * cos], axis=-1).astype(x.dtype)


def swiglu(x, w_gate, w_up, w_down):
    return (jax.nn.silu(x @ w_gate) * (x @ w_up)) @ w_down


def sweep_query_blocks(fn, bsz, seq):
    out = lax.map(fn, jnp.arange(seq // Q_BLOCK) * Q_BLOCK)
    return jnp.moveaxis(out, 0, 1).reshape(bsz, seq, -1)


def chunk_relpos_attention(q, k, v, rel_bias):
    bsz, seq, h, d = q.shape
    nc = seq // CHUNK
    nb = A_LEFT_CHUNKS + 1
    pad = A_LEFT_CHUNKS * CHUNK
    qc = q.reshape(bsz, nc, CHUNK, h, d)
    kp = jnp.pad(k, ((0, 0), (pad, 0), (0, 0), (0, 0))).reshape(bsz, nc + A_LEFT_CHUNKS, CHUNK, h, d)
    vp = jnp.pad(v, ((0, 0), (pad, 0), (0, 0), (0, 0))).reshape(bsz, nc + A_LEFT_CHUNKS, CHUNK, h, d)
    kb = jnp.stack([kp[:, j:j + nc] for j in range(nb)], axis=2).reshape(bsz, nc, nb * CHUNK, h, d)
    vb = jnp.stack([vp[:, j:j + nc] for j in range(nb)], axis=2).reshape(bsz, nc, nb * CHUNK, h, d)
    s = jnp.einsum('bcqhd,bckhd->bhcqk', qc, kb).astype(jnp.float32) * (d ** -0.5)
    qi = jnp.arange(CHUNK)[:, None]
    ki = jnp.arange(nb * CHUNK)[None, :]
    rel = pad + qi - ki
    ridx = jnp.clip(rel, -(CHUNK - 1), A_REL_MAX) + (CHUNK - 1)
    bias = rel_bias.astype(jnp.float32)[:, ridx]
    valid = (jnp.arange(nc)[:, None] + ki // CHUNK - A_LEFT_CHUNKS) >= 0
    s = jnp.where(valid[None, None, :, None, :], s + bias[None, :, None], NEG)
    p = jax.nn.softmax(s, axis=-1).astype(v.dtype)
    o = jnp.einsum('bhcqk,bckhd->bcqhd', p, vb)
    return o.reshape(bsz, seq, h * d)


def dsa_attention(q, k, v, q_idx, k_idx, w_idx):
    bsz, seq, h, d = q.shape
    topk = min(TOPK_MAX, seq // 4)
    kchunk = jnp.arange(seq) // CHUNK
    gather = jax.vmap(lambda kk, ii: kk[ii])

    def block(q0):
        tc = (q0 + jnp.arange(Q_BLOCK)) // CHUNK
        qi = lax.dynamic_slice_in_dim(q_idx, q0, Q_BLOCK, axis=1)
        wi = lax.dynamic_slice_in_dim(w_idx, q0, Q_BLOCK, axis=1).astype(jnp.float32) * (IDX_HEADS ** -0.5)
        qb = lax.dynamic_slice_in_dim(q, q0, Q_BLOCK, axis=1)
        dots = jnp.einsum('bqhd,bsd->bqhs', qi, k_idx).astype(jnp.float32) * (IDX_DIM ** -0.5)
        score = jnp.einsum('bqh,bqhs->bqs', wi, jax.nn.relu(dots))
        adm = kchunk[None, :] <= tc[:, None]
        score = jnp.where(adm[None], score, NEG)
        _, idx = lax.top_k(score, topk)
        ksel = gather(k, idx)
        vsel = gather(v, idx)
        valid = (idx // CHUNK) <= tc[None, :, None]
        s = jnp.einsum('bqhd,bqkhd->bhqk', qb, ksel).astype(jnp.float32) * (d ** -0.5)
        s = jnp.where(valid[:, None], s, NEG)
        p = jax.nn.softmax(s, axis=-1).astype(v.dtype)
        return jnp.einsum('bhqk,bqkhd->bqhd', p, vsel)

    return sweep_query_blocks(block, bsz, seq)


def mla_attention(c_q, c_kv, k_rope, q_norm, kv_norm, w_uq, w_ukv, pos):
    bsz, seq, _ = c_q.shape
    q = (rmsnorm(c_q, q_norm) @ w_uq).reshape(bsz, seq, C_HEADS, C_NOPE + C_ROPE)
    qn, qr = q[..., :C_NOPE], rope(q[..., C_NOPE:], pos)
    kv = (rmsnorm(c_kv, kv_norm) @ w_ukv).reshape(bsz, seq, C_HEADS, C_NOPE + C_V)
    kn, v = kv[..., :C_NOPE], kv[..., C_NOPE:]
    kr = rope(k_rope[:, :, None, :], pos)[:, :, 0, :]
    kchunk = pos // CHUNK
    scale = (C_NOPE + C_ROPE) ** -0.5

    def block(q0):
        tc = (q0 + jnp.arange(Q_BLOCK)) // CHUNK
        qnb = lax.dynamic_slice_in_dim(qn, q0, Q_BLOCK, axis=1)
        qrb = lax.dynamic_slice_in_dim(qr, q0, Q_BLOCK, axis=1)
        s = (jnp.einsum('bqhd,bshd->bhqs', qnb, kn) + jnp.einsum('bqhr,bsr->bhqs', qrb, kr)).astype(jnp.float32) * scale
        s = jnp.where((kchunk[None, :] <= tc[:, None])[None, None], s, NEG)
        p = jax.nn.softmax(s, axis=-1).astype(v.dtype)
        return jnp.einsum('bhqs,bshd->bqhd', p, v)

    return sweep_query_blocks(block, bsz, seq)


def split_columns(h):
    parts, off = [], 0
    for size in IN_SIZES:
        parts.append(h[..., off:off + size])
        off += size
    return parts


def hybrid_layer(x, pos, ffn1_norm, ffn1_w_gate, ffn1_w_up, ffn1_w_down, mix_norm, w_in, a_rel_bias,
                 c_q_norm, c_kv_norm, c_w_uq, c_w_ukv, w_out, ffn2_norm, ffn2_w_gate, ffn2_w_up, ffn2_w_down):
    bsz, seq, _ = x.shape
    x = x + 0.5 * swiglu(rmsnorm(x, ffn1_norm), ffn1_w_gate, ffn1_w_up, ffn1_w_down)
    h = rmsnorm(x, mix_norm) @ w_in
    (a_q, a_k, a_v, b_q, b_k, b_v, i_q, i_k, i_w, c_q, c_kv, c_kr) = split_columns(h)
    hd4 = lambda t, nh: t.reshape(bsz, seq, nh, -1)
    o_a = chunk_relpos_attention(hd4(a_q, A_HEADS), hd4(a_k, A_HEADS), hd4(a_v, A_HEADS), a_rel_bias)
    o_b = dsa_attention(rope(hd4(b_q, B_HEADS), pos), rope(hd4(b_k, B_HEADS), pos), hd4(b_v, B_HEADS),
                        rope(hd4(i_q, IDX_HEADS), pos), rope(i_k[:, :, None, :], pos)[:, :, 0, :], i_w)
    o_c = mla_attention(c_q, c_kv, c_kr, c_q_norm, c_kv_norm, c_w_uq, c_w_ukv, pos)
    x = x + jnp.concatenate([o_a, o_b, o_c], axis=-1) @ w_out
    x = x + 0.5 * swiglu(rmsnorm(x, ffn2_norm), ffn2_w_gate, ffn2_w_up, ffn2_w_down)
    return x


def setup_inputs(seed: int = 0) -> dict:
    key = jax.random.key(seed)
    ks = jax.random.split(key, 20)
    f32 = jnp.float32

    def nrm(k, shape, scale):
        return jax.random.normal(k, shape, f32) * scale

    def gain(k, n):
        return 1.0 + 0.02 * jax.random.normal(k, (DEPTH, n), f32)

    return {
        "x": jax.random.normal(ks[0], (BATCH, SEQ, D_MODEL), f32),
        "ffn1_norm": gain(ks[1], D_MODEL),
        "ffn1_w_gate": nrm(ks[2], (DEPTH, D_MODEL, D_FF), D_MODEL ** -0.5),
        "ffn1_w_up": nrm(ks[3], (DEPTH, D_MODEL, D_FF), D_MODEL ** -0.5),
        "ffn1_w_down": nrm(ks[4], (DEPTH, D_FF, D_MODEL), D_FF ** -0.5),
        "mix_norm": gain(ks[5], D_MODEL),
        "w_in": nrm(ks[6], (DEPTH, D_MODEL, D_IN), D_MODEL ** -0.5),
        "a_rel_bias": nrm(ks[7], (DEPTH, A_HEADS, A_NUM_REL), 0.1),
        "c_q_norm": gain(ks[8], C_Q_RANK),
        "c_kv_norm": gain(ks[9], C_KV_RANK),
        "c_w_uq": nrm(ks[10], (DEPTH, C_Q_RANK, C_HEADS * (C_NOPE + C_ROPE)), C_Q_RANK ** -0.5),
        "c_w_ukv": nrm(ks[11], (DEPTH, C_KV_RANK, C_HEADS * (C_NOPE + C_V)), C_KV_RANK ** -0.5),
        "w_out": nrm(ks[12], (DEPTH, D_MIX, D_MODEL), D_MIX ** -0.5),
        "ffn2_norm": gain(ks[13], D_MODEL),
        "ffn2_w_gate": nrm(ks[14], (DEPTH, D_MODEL, D_FF), D_MODEL ** -0.5),
        "ffn2_w_up": nrm(ks[15], (DEPTH, D_MODEL, D_FF), D_MODEL ** -0.5),
        "ffn2_w_down": nrm(ks[16], (DEPTH, D_FF, D_MODEL), D_FF ** -0.5),
        "final_norm": 1.0 + 0.02 * jax.random.normal(ks[17], (D_MODEL,), f32),
    }


def reference(x, ffn1_norm, ffn1_w_gate, ffn1_w_up, ffn1_w_down, mix_norm, w_in, a_rel_bias,
              c_q_norm, c_kv_norm, c_w_uq, c_w_ukv, w_out, ffn2_norm, ffn2_w_gate, ffn2_w_up,
              ffn2_w_down, final_norm):
    pos = jnp.arange(x.shape[1], dtype=jnp.int32)
    for l in range(DEPTH):
        x = hybrid_layer(x, pos, ffn1_norm[l], ffn1_w_gate[l], ffn1_w_up[l], ffn1_w_down[l], mix_norm[l],
                         w_in[l], a_rel_bias[l], c_q_norm[l], c_kv_norm[l], c_w_uq[l], c_w_ukv[l], w_out[l],
                         ffn2_norm[l], ffn2_w_gate[l], ffn2_w_up[l], ffn2_w_down[l])
    return rmsnorm(x, final_norm)
```

```cpp
#include <hip/hip_runtime.h>
#include <cstdio>
#include <cstdint>

#define LAS __attribute__((address_space(3)))
#define GAS __attribute__((address_space(1)))
typedef unsigned short bf16_t;
typedef short bf16x8 __attribute__((ext_vector_type(8)));
typedef short s16x4 __attribute__((ext_vector_type(4)));
typedef float f32x4 __attribute__((ext_vector_type(4)));
typedef float f32x2 __attribute__((ext_vector_type(2)));
typedef float f32x16 __attribute__((ext_vector_type(16)));
typedef unsigned u32x4 __attribute__((ext_vector_type(4)));
typedef unsigned u32x2 __attribute__((ext_vector_type(2)));
typedef unsigned u32x16 __attribute__((ext_vector_type(16)));

constexpr int BATCH = 4, SEQ = 8192, DM = 1024, DEPTH = 2, FF = 2816;
constexpr int M = BATCH * SEQ;
constexpr int NIN = 3072;
constexpr float EPS = 1e-6f;
constexpr float LOG2E = 1.4426950408889634f;
constexpr float C2_64 = 0.125f * LOG2E;
constexpr float C2_96 = 0.10206207261596575f * LOG2E;
constexpr int NWAVES = 8;
#ifndef F8_GU_MASK
#define F8_GU_MASK 0x8
#endif
#ifndef F8_D_MASK
#define F8_D_MASK 0xE
#endif
__host__ __device__ constexpr bool d_is_f8(int layer, int which  ) { return ((F8_D_MASK >> (2 * layer + which)) & 1) != 0; }
__host__ __device__ constexpr bool gu_is_f8(int layer, int which) { return ((F8_GU_MASK >> (2 * layer + which)) & 1) != 0 && (2 * layer + which) != 0; }
#ifndef F8_WIN_MASK
#define F8_WIN_MASK 0x0
#endif
__host__ __device__ constexpr bool win_is_f8(int layer) { return ((F8_WIN_MASK >> layer) & 1) != 0; }
constexpr int WIN_F8_TILES = 10; constexpr float WIN_F8_SCALE = 256.0f;
#ifndef F8_WO_MASK
#define F8_WO_MASK 0x2
#endif
__host__ __device__ constexpr bool wo_is_f8(int layer) { return ((F8_WO_MASK >> layer) & 1) != 0; }
constexpr float O_F8_SCALE = 128.0f, WO_F8_SCALE = 256.0f;
constexpr size_t DOUT_XB8 = 0, DOUT_O8 = 32u << 20;
constexpr float X_F8_SCALE = 16.0f, WGU_F8_SCALE = 256.0f;
constexpr float ACT_F8_SCALE = 4.0f, WD_F8_SCALE = 256.0f;

constexpr size_t MiB = 1u << 20;
constexpr size_t WS_CTL = 0, CTL_ZERO_BYTES = 1 * MiB;
constexpr size_t WS_W = 1 * MiB, W_LAYER = 43 * MiB;
constexpr size_t W_GU1 = 0, W_D1 = 11 * MiB, W_IN = 16 * MiB + MiB / 2, W_UQ = 23 * MiB, W_IW = 23 * MiB + 448 * 1024  , W_UKV = 23 * MiB + MiB / 2, W_OUT = 24 * MiB, W_GU2 = 26 * MiB, W_D2 = 37 * MiB;
constexpr size_t WS_TAB64 = 87 * MiB, WS_TAB32 = 89 * MiB;
constexpr size_t WS_XB = 90 * MiB;
constexpr size_t WS_STATX = 154 * MiB;
constexpr size_t WS_STATC = 156 * MiB;
constexpr size_t WS_U = 160 * MiB;
constexpr size_t WS_ACT = WS_U;
constexpr size_t WS_QO = WS_U, WS_KA = WS_U + 74 * MiB, WS_VA = WS_U + 98 * MiB, WS_KB = WS_U + 122 * MiB, WS_VB = WS_U + 142 * MiB, WS_IQ = WS_U + 162 * MiB,
                 WS_IK = WS_U + 178 * MiB, WS_IW = WS_U + 180 * MiB, WS_CQ = WS_U + 182 * MiB, WS_CKV = WS_U + 206 * MiB, WS_KN = WS_U + 222 * MiB, WS_VC = WS_U + 242 * MiB,
                 WS_KR = WS_U + 262 * MiB, WS_BM = WS_U + 264 * MiB  , WS_END = WS_U + 328 * MiB;
constexpr int QO_PITCH = 1184;
static_assert(WS_ACT + (size_t)M * FF * 2 <= WS_END && WS_QO + (size_t)M * QO_PITCH * 2 <= WS_KA, "ws map");
constexpr int CW_BAR = 4096;
constexpr int CW_Q = 16384;

enum { B_QO, B_KA, B_VA, B_KB, B_VB, B_IQ, B_IK, B_IW, B_CQ, B_CKV, B_KN, B_VC, B_KR, B_NBUF };
__device__ const unsigned long long BUF_OFF[B_NBUF] = { WS_QO, WS_KA, WS_VA, WS_KB, WS_VB, WS_IQ, WS_IK, WS_IW, WS_CQ, WS_CKV, WS_KN, WS_VC, WS_KR };
__device__ const int BUF_PITCH[B_NBUF] = { QO_PITCH, 384, 384, 320, 320, 256, 32, 16, 384, 256, 320, 320, 32 };
struct Desc { short buf0, buf1, col0, col1, rope, j0, stat0, stat1, scale0, scale1, f32; };
__device__ const short WIN_SRC[3072] = {
 1152,1153,1154,1155,1156,1157,1158,1159,1160,1161,1162,1163,1164,1165,1166,1167,1168,1169,1170,1171,1172,1173,1174,1175,1176,1177,1178,1179,1180,1181,1182,1183,
 1216,1217,1218,1219,1220,1221,1222,1223,1224,1225,1226,1227,1228,1229,1230,1231,1232,1233,1234,1235,1236,1237,1238,1239,1240,1241,1242,1243,1244,1245,1246,1247,
 1280,1281,1282,1283,1284,1285,1286,1287,1288,1289,1290,1291,1292,1293,1294,1295,1296,1297,1298,1299,1300,1301,1302,1303,1304,1305,1306,1307,1308,1309,1310,1311,
 1344,1345,1346,1347,1348,1349,1350,1351,1352,1353,1354,1355,1356,1357,1358,1359,1360,1361,1362,1363,1364,1365,1366,1367,1368,1369,1370,1371,1372,1373,1374,1375,
 1184,1185,1186,1187,1188,1189,1190,1191,1192,1193,1194,1195,1196,1197,1198,1199,1200,1201,1202,1203,1204,1205,1206,1207,1208,1209,1210,1211,1212,1213,1214,1215,
 1248,1249,1250,1251,1252,1253,1254,1255,1256,1257,1258,1259,1260,1261,1262,1263,1264,1265,1266,1267,1268,1269,1270,1271,1272,1273,1274,1275,1276,1277,1278,1279,
 1312,1313,1314,1315,1316,1317,1318,1319,1320,1321,1322,1323,1324,1325,1326,1327,1328,1329,1330,1331,1332,1333,1334,1335,1336,1337,1338,1339,1340,1341,1342,1343,
 1376,1377,1378,1379,1380,1381,1382,1383,1384,1385,1386,1387,1388,1389,1390,1391,1392,1393,1394,1395,1396,1397,1398,1399,1400,1401,1402,1403,1404,1405,1406,1407,
 1408,1409,1410,1411,1412,1413,1414,1415,1416,1417,1418,1419,1420,1421,1422,1423,1424,1425,1426,1427,1428,1429,1430,1431,1432,1433,1434,1435,1436,1437,1438,1439,
 1472,1473,1474,1475,1476,1477,1478,1479,1480,1481,1482,1483,1484,1485,1486,1487,1488,1489,1490,1491,1492,1493,1494,1495,1496,1497,1498,1499,1500,1501,1502,1503,
 1536,1537,1538,1539,1540,1541,1542,1543,1544,1545,1546,1547,1548,1549,1550,1551,1552,1553,1554,1555,1556,1557,1558,1559,1560,1561,1562,1563,1564,1565,1566,1567,
 1600,1601,1602,1603,1604,1605,1606,1607,1608,1609,1610,1611,1612,1613,1614,1615,1616,1617,1618,1619,1620,1621,1622,1623,1624,1625,1626,1627,1628,1629,1630,1631,
 1440,1441,1442,1443,1444,1445,1446,1447,1448,1449,1450,1451,1452,1453,1454,1455,1456,1457,1458,1459,1460,1461,1462,1463,1464,1465,1466,1467,1468,1469,1470,1471,
 1504,1505,1506,1507,1508,1509,1510,1511,1512,1513,1514,1515,1516,1517,1518,1519,1520,1521,1522,1523,1524,1525,1526,1527,1528,1529,1530,1531,1532,1533,1534,1535,
 1568,1569,1570,1571,1572,1573,1574,1575,1576,1577,1578,1579,1580,1581,1582,1583,1584,1585,1586,1587,1588,1589,1590,1591,1592,1593,1594,1595,1596,1597,1598,1599,
 1632,1633,1634,1635,1636,1637,1638,1639,1640,1641,1642,1643,1644,1645,1646,1647,1648,1649,1650,1651,1652,1653,1654,1655,1656,1657,1658,1659,1660,1661,1662,1663,
 0,1,2,3,4,5,6,7,8,9,10,11,12,13,14,15,16,17,18,19,20,21,22,23,24,25,26,27,28,29,30,31,
 32,33,34,35,36,37,38,39,40,41,42,43,44,45,46,47,48,49,50,51,52,53,54,55,56,57,58,59,60,61,62,63,
 64,65,66,67,68,69,70,71,72,73,74,75,76,77,78,79,80,81,82,83,84,85,86,87,88,89,90,91,92,93,94,95,
 96,97,98,99,100,101,102,103,104,105,106,107,108,109,110,111,112,113,114,115,116,117,118,119,120,121,122,123,124,125,126,127,
 128,129,130,131,132,133,134,135,136,137,138,139,140,141,142,143,144,145,146,147,148,149,150,151,152,153,154,155,156,157,158,159,
 160,161,162,163,164,165,166,167,168,169,170,171,172,173,174,175,176,177,178,179,180,181,182,183,184,185,186,187,188,189,190,191,
 192,193,194,195,196,197,198,199,200,201,202,203,204,205,206,207,208,209,210,211,212,213,214,215,216,217,218,219,220,221,222,223,
 224,225,226,227,228,229,230,231,232,233,234,235,236,237,238,239,240,241,242,243,244,245,246,247,248,249,250,251,252,253,254,255,
 256,257,258,259,260,261,262,263,264,265,266,267,268,269,270,271,272,273,274,275,276,277,278,279,280,281,282,283,284,285,286,287,
 288,289,290,291,292,293,294,295,296,297,298,299,300,301,302,303,304,305,306,307,308,309,310,311,312,313,314,315,316,317,318,319,
 320,321,322,323,324,325,326,327,328,329,330,331,332,333,334,335,336,337,338,339,340,341,342,343,344,345,346,347,348,349,350,351,
 352,353,354,355,356,357,358,359,360,361,362,363,364,365,366,367,368,369,370,371,372,373,374,375,376,377,378,379,380,381,382,383,
 384,385,386,387,388,389,390,391,392,393,394,395,396,397,398,399,400,401,402,403,404,405,406,407,408,409,410,411,412,413,414,415,
 416,417,418,419,420,421,422,423,424,425,426,427,428,429,430,431,432,433,434,435,436,437,438,439,440,441,442,443,444,445,446,447,
 448,449,450,451,452,453,454,455,456,457,458,459,460,461,462,463,464,465,466,467,468,469,470,471,472,473,474,475,476,477,478,479,
 480,481,482,483,484,485,486,487,488,489,490,491,492,493,494,495,496,497,498,499,500,501,502,503,504,505,506,507,508,509,510,511,
 512,513,514,515,516,517,518,519,520,521,522,523,524,525,526,527,528,529,530,531,532,533,534,535,536,537,538,539,540,541,542,543,
 544,545,546,547,548,549,550,551,552,553,554,555,556,557,558,559,560,561,562,563,564,565,566,567,568,569,570,571,572,573,574,575,
 576,577,578,579,580,581,582,583,584,585,586,587,588,589,590,591,592,593,594,595,596,597,598,599,600,601,602,603,604,605,606,607,
 608,609,610,611,612,613,614,615,616,617,618,619,620,621,622,623,624,625,626,627,628,629,630,631,632,633,634,635,636,637,638,639,
 640,641,642,643,644,645,646,647,648,649,650,651,652,653,654,655,656,657,658,659,660,661,662,663,664,665,666,667,668,669,670,671,
 672,673,674,675,676,677,678,679,680,681,682,683,684,685,686,687,688,689,690,691,692,693,694,695,696,697,698,699,700,701,702,703,
 704,705,706,707,708,709,710,711,712,713,714,715,716,717,718,719,720,721,722,723,724,725,726,727,728,729,730,731,732,733,734,735,
 736,737,738,739,740,741,742,743,744,745,746,747,748,749,750,751,752,753,754,755,756,757,758,759,760,761,762,763,764,765,766,767,
 768,769,770,771,772,773,774,775,776,777,778,779,780,781,782,783,784,785,786,787,788,789,790,791,792,793,794,795,796,797,798,799,
 800,801,802,803,804,805,806,807,808,809,810,811,812,813,814,815,816,817,818,819,820,821,822,823,824,825,826,827,828,829,830,831,
 832,833,834,835,836,837,838,839,840,841,842,843,844,845,846,847,848,849,850,851,852,853,854,855,856,857,858,859,860,861,862,863,
 864,865,866,867,868,869,870,871,872,873,874,875,876,877,878,879,880,881,882,883,884,885,886,887,888,889,890,891,892,893,894,895,
 896,897,898,899,900,901,902,903,904,905,906,907,908,909,910,911,912,913,914,915,916,917,918,919,920,921,922,923,924,925,926,927,
 928,929,930,931,932,933,934,935,936,937,938,939,940,941,942,943,944,945,946,947,948,949,950,951,952,953,954,955,956,957,958,959,
 960,961,962,963,964,965,966,967,968,969,970,971,972,973,974,975,976,977,978,979,980,981,982,983,984,985,986,987,988,989,990,991,
 992,993,994,995,996,997,998,999,1000,1001,1002,1003,1004,1005,1006,1007,1008,1009,1010,1011,1012,1013,1014,1015,1016,1017,1018,1019,1020,1021,1022,1023,
 1024,1025,1026,1027,1028,1029,1030,1031,1032,1033,1034,1035,1036,1037,1038,1039,1040,1041,1042,1043,1044,1045,1046,1047,1048,1049,1050,1051,1052,1053,1054,1055,
 1056,1057,1058,1059,1060,1061,1062,1063,1064,1065,1066,1067,1068,1069,1070,1071,1072,1073,1074,1075,1076,1077,1078,1079,1080,1081,1082,1083,1084,1085,1086,1087,
 1088,1089,1090,1091,1092,1093,1094,1095,1096,1097,1098,1099,1100,1101,1102,1103,1104,1105,1106,1107,1108,1109,1110,1111,1112,1113,1114,1115,1116,1117,1118,1119,
 1120,1121,1122,1123,1124,1125,1126,1127,1128,1129,1130,1131,1132,1133,1134,1135,1136,1137,1138,1139,1140,1141,1142,1143,1144,1145,1146,1147,1148,1149,1150,1151,
 1792,1793,1794,1795,1796,1797,1798,1799,1800,1801,1802,1803,1804,1805,1806,1807,1808,1809,1810,1811,1812,1813,1814,1815,1816,1817,1818,1819,1820,1821,1822,1823,
 1824,1825,1826,1827,1828,1829,1830,1831,1832,1833,1834,1835,1836,1837,1838,1839,1840,1841,1842,1843,1844,1845,1846,1847,1848,1849,1850,1851,1852,1853,1854,1855,
 1856,1857,1858,1859,1860,1861,1862,1863,1864,1865,1866,1867,1868,1869,1870,1871,1872,1873,1874,1875,1876,1877,1878,1879,1880,1881,1882,1883,1884,1885,1886,1887,
 1888,1889,1890,1891,1892,1893,1894,1895,1896,1897,1898,1899,1900,1901,1902,1903,1904,1905,1906,1907,1908,1909,1910,1911,1912,1913,1914,1915,1916,1917,1918,1919,
 1920,1921,1922,1923,1924,1925,1926,1927,1928,1929,1930,1931,1932,1933,1934,1935,1936,1937,1938,1939,1940,1941,1942,1943,1944,1945,1946,1947,1948,1949,1950,1951,
 1952,1953,1954,1955,1956,1957,1958,1959,1960,1961,1962,1963,1964,1965,1966,1967,1968,1969,1970,1971,1972,1973,1974,1975,1976,1977,1978,1979,1980,1981,1982,1983,
 1984,1985,1986,1987,1988,1989,1990,1991,1992,1993,1994,1995,1996,1997,1998,1999,2000,2001,2002,2003,2004,2005,2006,2007,2008,2009,2010,2011,2012,2013,2014,2015,
 2016,2017,2018,2019,2020,2021,2022,2023,2024,2025,2026,2027,2028,2029,2030,2031,2032,2033,2034,2035,2036,2037,2038,2039,2040,2041,2042,2043,2044,2045,2046,2047,
 2408,2409,2410,2411,2412,2413,2414,2415,2416,2417,2418,2419,2420,2421,2422,2423,2424,2425,2426,2427,2428,2429,2430,2431,2432,2433,2434,2435,2436,2437,2438,2439,
 2440,2441,2442,2443,2444,2445,2446,2447,2448,2449,2450,2451,2452,2453,2454,2455,2456,2457,2458,2459,2460,2461,2462,2463,2464,2465,2466,2467,2468,2469,2470,2471,
 2472,2473,2474,2475,2476,2477,2478,2479,2480,2481,2482,2483,2484,2485,2486,2487,2488,2489,2490,2491,2492,2493,2494,2495,2496,2497,2498,2499,2500,2501,2502,2503,
 2504,2505,2506,2507,2508,2509,2510,2511,2512,2513,2514,2515,2516,2517,2518,2519,2520,2521,2522,2523,2524,2525,2526,2527,2528,2529,2530,2531,2532,2533,2534,2535,
 2536,2537,2538,2539,2540,2541,2542,2543,2544,2545,2546,2547,2548,2549,2550,2551,2552,2553,2554,2555,2556,2557,2558,2559,2560,2561,2562,2563,2564,2565,2566,2567,
 2568,2569,2570,2571,2572,2573,2574,2575,2576,2577,2578,2579,2580,2581,2582,2583,2584,2585,2586,2587,2588,2589,2590,2591,2592,2593,2594,2595,2596,2597,2598,2599,
 2600,2601,2602,2603,2604,2605,2606,2607,2608,2609,2610,2611,2612,2613,2614,2615,2616,2617,2618,2619,2620,2621,2622,2623,2624,2625,2626,2627,2628,2629,2630,2631,
 2632,2633,2634,2635,2636,2637,2638,2639,2640,2641,2642,2643,2644,2645,2646,2647,2648,2649,2650,2651,2652,2653,2654,2655,2656,2657,2658,2659,2660,2661,2662,2663,
 2664,2665,2666,2667,2668,2669,2670,2671,2672,2673,2674,2675,2676,2677,2678,2679,2680,2681,2682,2683,2684,2685,2686,2687,2688,2689,2690,2691,2692,2693,2694,2695,
 2696,2697,2698,2699,2700,2701,2702,2703,2704,2705,2706,2707,2708,2709,2710,2711,2712,2713,2714,2715,2716,2717,2718,2719,2720,2721,2722,2723,2724,2725,2726,2727,
 2728,2729,2730,2731,2732,2733,2734,2735,2736,2737,2738,2739,2740,2741,2742,2743,2744,2745,2746,2747,2748,2749,2750,2751,2752,2753,2754,2755,2756,2757,2758,2759,
 2760,2761,2762,2763,2764,2765,2766,2767,2768,2769,2770,2771,2772,2773,2774,2775,2776,2777,2778,2779,2780,2781,2782,2783,2784,2785,2786,2787,2788,2789,2790,2791,
 2792,2793,2794,2795,2796,2797,2798,2799,2800,2801,2802,2803,2804,2805,2806,2807,2808,2809,2810,2811,2812,2813,2814,2815,2816,2817,2818,2819,2820,2821,2822,2823,
 2824,2825,2826,2827,2828,2829,2830,2831,2832,2833,2834,2835,2836,2837,2838,2839,2840,2841,2842,2843,2844,2845,2846,2847,2848,2849,2850,2851,2852,2853,2854,2855,
 2856,2857,2858,2859,2860,2861,2862,2863,2864,2865,2866,2867,2868,2869,2870,2871,2872,2873,2874,2875,2876,2877,2878,2879,2880,2881,2882,2883,2884,2885,2886,2887,
 2888,2889,2890,2891,2892,2893,2894,2895,2896,2897,2898,2899,2900,2901,2902,2903,2904,2905,2906,2907,2908,2909,2910,2911,2912,2913,2914,2915,2916,2917,2918,2919,
 2920,2921,2922,2923,2924,2925,2926,2927,2928,2929,2930,2931,2932,2933,2934,2935,2936,2937,2938,2939,2940,2941,2942,2943,2944,2945,2946,2947,2948,2949,2950,2951,
 2952,2953,2954,2955,2956,2957,2958,2959,2960,2961,2962,2963,2964,2965,2966,2967,2968,2969,2970,2971,2972,2973,2974,2975,2976,2977,2978,2979,2980,2981,2982,2983,
 2984,2985,2986,2987,2988,2989,2990,2991,2992,2993,2994,2995,2996,2997,2998,2999,3000,3001,3002,3003,3004,3005,3006,3007,3008,3009,3010,3011,3012,3013,3014,3015,
 3016,3017,3018,3019,3020,3021,3022,3023,3024,3025,3026,3027,3028,3029,3030,3031,3032,3033,3034,3035,3036,3037,3038,3039,3040,3041,3042,3043,3044,3045,3046,3047,
 1664,1665,1666,1667,1668,1669,1670,1671,1672,1673,1674,1675,1676,1677,1678,1679,1680,1681,1682,1683,1684,1685,1686,1687,1688,1689,1690,1691,1692,1693,1694,1695,
 1728,1729,1730,1731,1732,1733,1734,1735,1736,1737,1738,1739,1740,1741,1742,1743,1744,1745,1746,1747,1748,1749,1750,1751,1752,1753,1754,1755,1756,1757,1758,1759,
 2112,2113,2114,2115,2116,2117,2118,2119,2120,2121,2122,2123,2124,2125,2126,2127,2144,2145,2146,2147,2148,2149,2150,2151,2152,2153,2154,2155,2156,2157,2158,2159,
 2176,2177,2178,2179,2180,2181,2182,2183,2184,2185,2186,2187,2188,2189,2190,2191,2208,2209,2210,2211,2212,2213,2214,2215,2216,2217,2218,2219,2220,2221,2222,2223,
 1696,1697,1698,1699,1700,1701,1702,1703,1704,1705,1706,1707,1708,1709,1710,1711,1712,1713,1714,1715,1716,1717,1718,1719,1720,1721,1722,1723,1724,1725,1726,1727,
 1760,1761,1762,1763,1764,1765,1766,1767,1768,1769,1770,1771,1772,1773,1774,1775,1776,1777,1778,1779,1780,1781,1782,1783,1784,1785,1786,1787,1788,1789,1790,1791,
 2128,2129,2130,2131,2132,2133,2134,2135,2136,2137,2138,2139,2140,2141,2142,2143,2160,2161,2162,2163,2164,2165,2166,2167,2168,2169,2170,2171,2172,2173,2174,2175,
 2192,2193,2194,2195,2196,2197,2198,2199,2200,2201,2202,2203,2204,2205,2206,2207,2224,2225,2226,2227,2228,2229,2230,2231,2232,2233,2234,2235,2236,2237,2238,2239,
 2240,2241,2242,2243,2244,2245,2246,2247,2248,2249,2250,2251,2252,2253,2254,2255,2272,2273,2274,2275,2276,2277,2278,2279,2280,2281,2282,2283,2284,2285,2286,2287,
 2304,2305,2306,2307,2308,2309,2310,2311,2312,2313,2314,2315,2316,2317,2318,2319,2336,2337,2338,2339,2340,2341,2342,2343,2344,2345,2346,2347,2348,2349,2350,2351,
 2368,2369,2370,2371,2372,2373,2374,2375,2376,2377,2378,2379,2380,2381,2382,2383,3048,3049,3050,3051,3052,3053,3054,3055,3056,3057,3058,3059,3060,3061,3062,3063,
 2048,2049,2050,2051,2052,2053,2054,2055,2056,2057,2058,2059,2060,2061,2062,2063,2080,2081,2082,2083,2084,2085,2086,2087,2088,2089,2090,2091,2092,2093,2094,2095,
 2256,2257,2258,2259,2260,2261,2262,2263,2264,2265,2266,2267,2268,2269,2270,2271,2288,2289,2290,2291,2292,2293,2294,2295,2296,2297,2298,2299,2300,2301,2302,2303,
 2320,2321,2322,2323,2324,2325,2326,2327,2328,2329,2330,2331,2332,2333,2334,2335,2352,2353,2354,2355,2356,2357,2358,2359,2360,2361,2362,2363,2364,2365,2366,2367,
 2384,2385,2386,2387,2388,2389,2390,2391,2392,2393,2394,2395,2396,2397,2398,2399,3064,3065,3066,3067,3068,3069,3070,3071,3072,3073,3074,3075,3076,3077,3078,3079,
 2064,2065,2066,2067,2068,2069,2070,2071,2072,2073,2074,2075,2076,2077,2078,2079,2096,2097,2098,2099,2100,2101,2102,2103,2104,2105,2106,2107,2108,2109,2110,2111,
};
__device__ const Desc WIN_DESC[96] = {
  {0,0,384,416,1,0,-1,-1,1,1,0},
  {0,0,400,432,1,16,-1,-1,1,1,0},
  {0,0,448,480,1,0,-1,-1,1,1,0},
  {0,0,464,496,1,16,-1,-1,1,1,0},
  {0,0,512,544,1,0,-1,-1,1,1,0},
  {0,0,528,560,1,16,-1,-1,1,1,0},
  {0,0,576,608,1,0,-1,-1,1,1,0},
  {0,0,592,624,1,16,-1,-1,1,1,0},
  {0,0,640,672,1,0,-1,-1,1,1,0},
  {0,0,656,688,1,16,-1,-1,1,1,0},
  {3,3,0,32,1,0,-1,-1,0,0,0},
  {3,3,16,48,1,16,-1,-1,0,0,0},
  {3,3,64,96,1,0,-1,-1,0,0,0},
  {3,3,80,112,1,16,-1,-1,0,0,0},
  {3,3,128,160,1,0,-1,-1,0,0,0},
  {3,3,144,176,1,16,-1,-1,0,0,0},
  {0,0,0,128,0,0,-1,-1,1,1,0},
  {0,0,16,144,0,0,-1,-1,1,1,0},
  {0,0,32,160,0,0,-1,-1,1,1,0},
  {0,0,48,176,0,0,-1,-1,1,1,0},
  {0,0,64,192,0,0,-1,-1,1,1,0},
  {0,0,80,208,0,0,-1,-1,1,1,0},
  {0,0,96,224,0,0,-1,-1,1,1,0},
  {0,0,112,240,0,0,-1,-1,1,1,0},
  {0,1,256,0,0,0,-1,-1,1,0,0},
  {0,1,272,16,0,0,-1,-1,1,0,0},
  {0,1,288,32,0,0,-1,-1,1,0,0},
  {0,1,304,48,0,0,-1,-1,1,0,0},
  {0,1,320,64,0,0,-1,-1,1,0,0},
  {0,1,336,80,0,0,-1,-1,1,0,0},
  {0,1,352,96,0,0,-1,-1,1,0,0},
  {0,1,368,112,0,0,-1,-1,1,0,0},
  {1,1,128,256,0,0,-1,-1,0,0,0},
  {1,1,144,272,0,0,-1,-1,0,0,0},
  {1,1,160,288,0,0,-1,-1,0,0,0},
  {1,1,176,304,0,0,-1,-1,0,0,0},
  {1,1,192,320,0,0,-1,-1,0,0,0},
  {1,1,208,336,0,0,-1,-1,0,0,0},
  {1,1,224,352,0,0,-1,-1,0,0,0},
  {1,1,240,368,0,0,-1,-1,0,0,0},
  {2,2,0,128,0,0,-1,-1,0,0,0},
  {2,2,16,144,0,0,-1,-1,0,0,0},
  {2,2,32,160,0,0,-1,-1,0,0,0},
  {2,2,48,176,0,0,-1,-1,0,0,0},
  {2,2,64,192,0,0,-1,-1,0,0,0},
  {2,2,80,208,0,0,-1,-1,0,0,0},
  {2,2,96,224,0,0,-1,-1,0,0,0},
  {2,2,112,240,0,0,-1,-1,0,0,0},
  {2,4,256,0,0,0,-1,-1,0,0,0},
  {2,4,272,16,0,0,-1,-1,0,0,0},
  {2,4,288,32,0,0,-1,-1,0,0,0},
  {2,4,304,48,0,0,-1,-1,0,0,0},
  {2,4,320,64,0,0,-1,-1,0,0,0},
  {2,4,336,80,0,0,-1,-1,0,0,0},
  {2,4,352,96,0,0,-1,-1,0,0,0},
  {2,4,368,112,0,0,-1,-1,0,0,0},
  {4,8,128,0,0,0,-1,0,0,0,0},
  {4,8,144,16,0,0,-1,0,0,0,0},
  {4,8,160,32,0,0,-1,0,0,0,0},
  {4,8,176,48,0,0,-1,0,0,0,0},
  {4,8,192,64,0,0,-1,0,0,0,0},
  {4,8,208,80,0,0,-1,0,0,0,0},
  {4,8,224,96,0,0,-1,0,0,0,0},
  {4,8,240,112,0,0,-1,0,0,0,0},
  {8,8,128,256,0,0,4,8,0,0,0},
  {8,8,144,272,0,0,4,8,0,0,0},
  {8,8,160,288,0,0,4,8,0,0,0},
  {8,8,176,304,0,0,4,8,0,0,0},
  {8,8,192,320,0,0,4,8,0,0,0},
  {8,8,208,336,0,0,4,8,0,0,0},
  {8,8,224,352,0,0,4,8,0,0,0},
  {8,8,240,368,0,0,4,8,0,0,0},
  {9,9,0,128,0,0,16,20,0,0,0},
  {9,9,16,144,0,0,16,20,0,0,0},
  {9,9,32,160,0,0,16,20,0,0,0},
  {9,9,48,176,0,0,16,20,0,0,0},
  {9,9,64,192,0,0,16,20,0,0,0},
  {9,9,80,208,0,0,16,20,0,0,0},
  {9,9,96,224,0,0,16,20,0,0,0},
  {9,9,112,240,0,0,16,20,0,0,0},
  {3,3,192,224,1,0,-1,-1,0,0,0},
  {3,3,208,240,1,16,-1,-1,0,0,0},
  {3,3,256,288,1,0,-1,-1,0,0,0},
  {3,3,272,304,1,16,-1,-1,0,0,0},
  {5,5,0,16,2,0,-1,-1,0,0,0},
  {5,5,32,48,2,0,-1,-1,0,0,0},
  {5,5,64,80,2,0,-1,-1,0,0,0},
  {5,5,96,112,2,0,-1,-1,0,0,0},
  {5,5,128,144,2,0,-1,-1,0,0,0},
  {5,5,160,176,2,0,-1,-1,0,0,0},
  {5,5,192,208,2,0,-1,-1,0,0,0},
  {5,5,224,240,2,0,-1,-1,0,0,0},
  {6,6,0,16,2,0,-1,-1,0,0,0},
  {12,12,0,16,2,0,-1,-1,0,0,0},
  {4,4,256,272,0,0,-1,-1,0,0,0},
  {4,4,288,304,0,0,-1,-1,0,0,0},
};
__device__ const short WIW_SRC[32] = {
 2400,2401,2402,2403,2404,2405,2406,2407,-1,-1,-1,-1,-1,-1,-1,-1,-1,-1,-1,-1,-1,-1,-1,-1,-1,-1,-1,-1,-1,-1,-1,-1,
};
__device__ const short WUQ_SRC[512] = {
 0,1,2,3,4,5,6,7,8,9,10,11,12,13,14,15,16,17,18,19,20,21,22,23,24,25,26,27,28,29,30,31,
 32,33,34,35,36,37,38,39,40,41,42,43,44,45,46,47,48,49,50,51,52,53,54,55,56,57,58,59,60,61,62,63,
 96,97,98,99,100,101,102,103,104,105,106,107,108,109,110,111,112,113,114,115,116,117,118,119,120,121,122,123,124,125,126,127,
 128,129,130,131,132,133,134,135,136,137,138,139,140,141,142,143,144,145,146,147,148,149,150,151,152,153,154,155,156,157,158,159,
 192,193,194,195,196,197,198,199,200,201,202,203,204,205,206,207,208,209,210,211,212,213,214,215,216,217,218,219,220,221,222,223,
 224,225,226,227,228,229,230,231,232,233,234,235,236,237,238,239,240,241,242,243,244,245,246,247,248,249,250,251,252,253,254,255,
 288,289,290,291,292,293,294,295,296,297,298,299,300,301,302,303,304,305,306,307,308,309,310,311,312,313,314,315,316,317,318,319,
 320,321,322,323,324,325,326,327,328,329,330,331,332,333,334,335,336,337,338,339,340,341,342,343,344,345,346,347,348,349,350,351,
 64,65,66,67,68,69,70,71,72,73,74,75,76,77,78,79,160,161,162,163,164,165,166,167,168,169,170,171,172,173,174,175,
 256,257,258,259,260,261,262,263,264,265,266,267,268,269,270,271,352,353,354,355,356,357,358,359,360,361,362,363,364,365,366,367,
 448,449,450,451,452,453,454,455,456,457,458,459,460,461,462,463,384,385,386,387,388,389,390,391,392,393,394,395,396,397,398,399,
 400,401,402,403,404,405,406,407,408,409,410,411,412,413,414,415,416,417,418,419,420,421,422,423,424,425,426,427,428,429,430,431,
 80,81,82,83,84,85,86,87,88,89,90,91,92,93,94,95,176,177,178,179,180,181,182,183,184,185,186,187,188,189,190,191,
 272,273,274,275,276,277,278,279,280,281,282,283,284,285,286,287,368,369,370,371,372,373,374,375,376,377,378,379,380,381,382,383,
 464,465,466,467,468,469,470,471,472,473,474,475,476,477,478,479,432,433,434,435,436,437,438,439,440,441,442,443,444,445,446,447,
 -1,-1,-1,-1,-1,-1,-1,-1,-1,-1,-1,-1,-1,-1,-1,-1,-1,-1,-1,-1,-1,-1,-1,-1,-1,-1,-1,-1,-1,-1,-1,-1,
};
__device__ const Desc WUQ_DESC[16] = {
  {0,0,704,832,0,0,-1,-1,2,2,0},
  {0,0,720,848,0,0,-1,-1,2,2,0},
  {0,0,736,864,0,0,-1,-1,2,2,0},
  {0,0,752,880,0,0,-1,-1,2,2,0},
  {0,0,768,896,0,0,-1,-1,2,2,0},
  {0,0,784,912,0,0,-1,-1,2,2,0},
  {0,0,800,928,0,0,-1,-1,2,2,0},
  {0,0,816,944,0,0,-1,-1,2,2,0},
  {0,0,1024,1040,2,0,-1,-1,2,2,0},
  {0,0,1056,1072,2,0,-1,-1,2,2,0},
  {0,0,1088,1104,2,0,-1,-1,2,2,0},
  {0,0,1120,1136,2,0,-1,-1,2,2,0},
  {0,0,1152,1168,2,0,-1,-1,2,2,0},
  {0,0,960,1008,0,0,-1,-1,2,2,0},
  {0,-1,976,0,0,0,-1,-1,2,0,0},
  {0,-1,992,0,0,0,-1,-1,2,0,0},
};
__device__ const short WUKV_SRC[768] = {
 0,1,2,3,4,5,6,7,8,9,10,11,12,13,14,15,16,17,18,19,20,21,22,23,24,25,26,27,28,29,30,31,
 32,33,34,35,36,37,38,39,40,41,42,43,44,45,46,47,48,49,50,51,52,53,54,55,56,57,58,59,60,61,62,63,
 128,129,130,131,132,133,134,135,136,137,138,139,140,141,142,143,144,145,146,147,148,149,150,151,152,153,154,155,156,157,158,159,
 160,161,162,163,164,165,166,167,168,169,170,171,172,173,174,175,176,177,178,179,180,181,182,183,184,185,186,187,188,189,190,191,
 256,257,258,259,260,261,262,263,264,265,266,267,268,269,270,271,272,273,274,275,276,277,278,279,280,281,282,283,284,285,286,287,
 288,289,290,291,292,293,294,295,296,297,298,299,300,301,302,303,304,305,306,307,308,309,310,311,312,313,314,315,316,317,318,319,
 384,385,386,387,388,389,390,391,392,393,394,395,396,397,398,399,400,401,402,403,404,405,406,407,408,409,410,411,412,413,414,415,
 416,417,418,419,420,421,422,423,424,425,426,427,428,429,430,431,432,433,434,435,436,437,438,439,440,441,442,443,444,445,446,447,
 512,513,514,515,516,517,518,519,520,521,522,523,524,525,526,527,528,529,530,531,532,533,534,535,536,537,538,539,540,541,542,543,
 544,545,546,547,548,549,550,551,552,553,554,555,556,557,558,559,560,561,562,563,564,565,566,567,568,569,570,571,572,573,574,575,
 64,65,66,67,68,69,70,71,72,73,74,75,76,77,78,79,80,81,82,83,84,85,86,87,88,89,90,91,92,93,94,95,
 96,97,98,99,100,101,102,103,104,105,106,107,108,109,110,111,112,113,114,115,116,117,118,119,120,121,122,123,124,125,126,127,
 192,193,194,195,196,197,198,199,200,201,202,203,204,205,206,207,208,209,210,211,212,213,214,215,216,217,218,219,220,221,222,223,
 224,225,226,227,228,229,230,231,232,233,234,235,236,237,238,239,240,241,242,243,244,245,246,247,248,249,250,251,252,253,254,255,
 320,321,322,323,324,325,326,327,328,329,330,331,332,333,334,335,336,337,338,339,340,341,342,343,344,345,346,347,348,349,350,351,
 352,353,354,355,356,357,358,359,360,361,362,363,364,365,366,367,368,369,370,371,372,373,374,375,376,377,378,379,380,381,382,383,
 448,449,450,451,452,453,454,455,456,457,458,459,460,461,462,463,464,465,466,467,468,469,470,471,472,473,474,475,476,477,478,479,
 480,481,482,483,484,485,486,487,488,489,490,491,492,493,494,495,496,497,498,499,500,501,502,503,504,505,506,507,508,509,510,511,
 576,577,578,579,580,581,582,583,584,585,586,587,588,589,590,591,592,593,594,595,596,597,598,599,600,601,602,603,604,605,606,607,
 608,609,610,611,612,613,614,615,616,617,618,619,620,621,622,623,624,625,626,627,628,629,630,631,632,633,634,635,636,637,638,639,
 -1,-1,-1,-1,-1,-1,-1,-1,-1,-1,-1,-1,-1,-1,-1,-1,-1,-1,-1,-1,-1,-1,-1,-1,-1,-1,-1,-1,-1,-1,-1,-1,
 -1,-1,-1,-1,-1,-1,-1,-1,-1,-1,-1,-1,-1,-1,-1,-1,-1,-1,-1,-1,-1,-1,-1,-1,-1,-1,-1,-1,-1,-1,-1,-1,
 -1,-1,-1,-1,-1,-1,-1,-1,-1,-1,-1,-1,-1,-1,-1,-1,-1,-1,-1,-1,-1,-1,-1,-1,-1,-1,-1,-1,-1,-1,-1,-1,
 -1,-1,-1,-1,-1,-1,-1,-1,-1,-1,-1,-1,-1,-1,-1,-1,-1,-1,-1,-1,-1,-1,-1,-1,-1,-1,-1,-1,-1,-1,-1,-1,
};
__device__ const Desc WUKV_DESC[24] = {
  {10,10,0,128,0,0,-1,-1,0,0,0},
  {10,10,16,144,0,0,-1,-1,0,0,0},
  {10,10,32,160,0,0,-1,-1,0,0,0},
  {10,10,48,176,0,0,-1,-1,0,0,0},
  {10,10,64,192,0,0,-1,-1,0,0,0},
  {10,10,80,208,0,0,-1,-1,0,0,0},
  {10,10,96,224,0,0,-1,-1,0,0,0},
  {10,10,112,240,0,0,-1,-1,0,0,0},
  {10,11,256,64,0,0,-1,-1,0,0,0},
  {10,11,272,80,0,0,-1,-1,0,0,0},
  {10,11,288,96,0,0,-1,-1,0,0,0},
  {10,11,304,112,0,0,-1,-1,0,0,0},
  {11,11,0,128,0,0,-1,-1,0,0,0},
  {11,11,16,144,0,0,-1,-1,0,0,0},
  {11,11,32,160,0,0,-1,-1,0,0,0},
  {11,11,48,176,0,0,-1,-1,0,0,0},
  {11,-1,192,0,0,0,-1,-1,0,0,0},
  {11,-1,208,0,0,0,-1,-1,0,0,0},
  {11,-1,224,0,0,0,-1,-1,0,0,0},
  {11,-1,240,0,0,0,-1,-1,0,0,0},
  {11,-1,256,0,0,0,-1,-1,0,0,0},
  {11,-1,272,0,0,0,-1,-1,0,0,0},
  {11,-1,288,0,0,0,-1,-1,0,0,0},
  {11,-1,304,0,0,0,-1,-1,0,0,0},
};
__device__ const double INV64[32] = {1,0.74989420933245587,0.56234132519034907,0.42169650342858223,0.31622776601683794,0.23713737056616552,0.17782794100389229,0.1333521432163324,0.10000000000000001,0.074989420933245579,0.056234132519034911,0.042169650342858224,0.031622776601683791,0.023713737056616554,0.017782794100389229,0.013335214321633241,0.01,0.0074989420933245579,0.005623413251903491,0.0042169650342858229,0.0031622776601683794,0.0023713737056616554,0.0017782794100389228,0.0013335214321633241,0.001,0.00074989420933245586,0.0005623413251903491,0.00042169650342858224,0.00031622776601683794,0.00023713737056616554,0.00017782794100389227,0.0001333521432163324};
__device__ const double INV32[16] = {1,0.56234132519034907,0.31622776601683794,0.17782794100389229,0.10000000000000001,0.056234132519034911,0.031622776601683791,0.017782794100389229,0.01,0.005623413251903491,0.0031622776601683794,0.0017782794100389228,0.001,0.0005623413251903491,0.00031622776601683794,0.00017782794100389227};
namespace pg8 {
#define PG8_LAS __attribute__((address_space(3)))
constexpr int BM = 256, BK = 64, HALF = 128, HTB = HALF * BK * 2  , STAGE_BYTES = 8 * HTB, NXCD = 8, WGM = 8;

__host__ __device__ __forceinline__ int lds_byte(int r, int c) { const int st = (r >> 4) * 2 + (c >> 5), rr = r & 15, cc = c & 31, ob = rr * 64 + cc * 2; return st * 1024 + (ob ^ (((ob >> 9) & 1) << 5)); }
__host__ __device__ __forceinline__ void stage_rc(int b, int& R, int& C) { const int st = b / 1024, sb = b % 1024, swz = sb ^ (((sb >> 9) & 1) << 5); R = (st >> 1) * 16 + swz / 64; C = (st & 1) * 32 + (swz % 64) / 2; }
__host__ __device__ __forceinline__ int perm32(int rho) { const int n = rho >> 4, i = rho & 15; return 8 * (i >> 2) + 4 * n + (i & 3); }
struct Unit { int pm, pn; };
struct Gemm { const bf16_t* A; const bf16_t* Bt; int M, N, K, lda; };
struct StaticOrder {
    int nM, nN, nwg, G, c;
    int pan = 0, pan_pm = 0;
    int pair = 0;
    __host__ __device__ void init(int M, int N, int G_, int c_) { nM = M / BM; nN = N / BM; nwg = nM * nN; G = G_; c = c_; }
    __host__ __device__ void init_pair(int M, int N, int G_, int c_) { init(M, N, G_, c_); pair = (G_ == 2 * nM && G_ % 8 == 0) ? 1 : 0; }
    __host__ __device__ void init_panel(int M, int N, int pm) { init(M, N, 0, 0); pan = 1; pan_pm = pm; }
    __host__ __device__ bool next(int i, Unit& u) const {
        if (pan) { if (i >= nN) return false; u.pm = pan_pm; u.pn = i; return true; }
        if (pair) { const int vcu = (c % 8) * (G / 8) + c / 8, pn = 2 * i + (vcu & 1); if (pn >= nN) return false; u.pm = vcu >> 1; u.pn = pn; return true; }
        const long L = (long)i * G + c; if (L >= nwg) return false;
        int wgid = (int)L; { const int q = nwg / NXCD, r = nwg % NXCD, xcd = wgid % NXCD, off = wgid / NXCD; wgid = (xcd < r ? xcd * (q + 1) : r * (q + 1) + (xcd - r) * q) + off; }
        const int nig = WGM * nN, gid = wgid / nig, fm = gid * WGM, gsz = (nM - fm) < WGM ? (nM - fm) : WGM;
        u.pm = fm + ((wgid % nig) % gsz); u.pn = (wgid % nig) / gsz; return true;
    }
    __device__ __forceinline__ void a_ready(const Unit&) const {}
    __device__ __forceinline__ void done(const Unit&) const {}
};
typedef __bf16 bf16x2_t __attribute__((ext_vector_type(2)));
__device__ __forceinline__ unsigned cvt_pk_bf16(float lo, float hi) { const f32x2 v = {lo, hi}; return __builtin_bit_cast(unsigned, __builtin_convertvector(v, bf16x2_t)); }
typedef int i32x4_t __attribute__((ext_vector_type(4)));
typedef int i32x8_t __attribute__((ext_vector_type(8)));
template <class Epi, class Sched, bool ALIGN_EPI = false, bool SP2 = false, bool FP8 = false>
__device__ __forceinline__ void gemm_phase(PG8_LAS unsigned char* lds, const Gemm g, const Sched& S, const Epi& E) {
    int tid_ = threadIdx.x; asm volatile("" : "+v"(tid_));
    const int tid = tid_, wid = __builtin_amdgcn_readfirstlane(tid >> 6), lane = tid & 63, wr = wid >> 2, wc = wid & 3, fr = lane & 15, fq = lane >> 4;
    const int K = g.K, nt = K / BK;
    unsigned voffA[2], voffB[2];
#pragma unroll
    for (int i = 0; i < 2; ++i) { int R, C; stage_rc(tid * 16 + i * 8192, R, C); const int Rb = Epi::PERM ? ((R & ~31) + perm32(R & 31)) : R;
        voffA[i] = (unsigned)(R * g.lda + C) * 2u; voffB[i] = (unsigned)(Rb * K + C) * 2u; }
    const size_t kstep = (size_t)(BK * 2);
    const size_t hstepB = (size_t)HALF * K * 2, hstepA = (size_t)HALF * g.lda * 2;
    const size_t tstepB = 2 * hstepB, tstepA = 2 * hstepA;
    const unsigned ldsw = (unsigned)wid * 1024u;
    const int aoff = lds_byte(wr * 64 + fr, fq * 8), boff = lds_byte(wc * 32 + fr, fq * 8);
#define PG8_SA(b, h) (((b) * 2 + (h)) * HTB)
#define PG8_SB(b, h) ((4 + (b) * 2 + (h)) * HTB)
#define PG8_STAGE(bufoff, gbase, voff) do { _Pragma("unroll") for (int _i = 0; _i < 2; ++_i) \
        __builtin_amdgcn_global_load_lds((const unsigned*)((const char*)(gbase) + (voff)[_i]), (PG8_LAS unsigned*)(lds + (bufoff) + ldsw + _i * 8192), 16, 0, 0); } while (0)
#define PG8_LDA(dst, b, h) do { if constexpr (FP8) { _Pragma("unroll") for (int m = 0; m < 4; ++m) { const PG8_LAS unsigned char* p_ = lds + PG8_SA(b, h) + aoff + m * 2048; \
        dst##8[m] = __builtin_shufflevector(*(const PG8_LAS i32x4_t*)p_, *(const PG8_LAS i32x4_t*)(p_ + 1024), 0, 1, 2, 3, 4, 5, 6, 7); } } \
    else { _Pragma("unroll") for (int m = 0; m < 4; ++m) _Pragma("unroll") for (int k = 0; k < 2; ++k) dst[m][k] = *(const PG8_LAS bf16x8*)(lds + PG8_SA(b, h) + aoff + m * 2048 + k * 1024); } } while (0)
#define PG8_LDB(dst, b, h) do { if constexpr (FP8) { _Pragma("unroll") for (int n = 0; n < 2; ++n) { const PG8_LAS unsigned char* p_ = lds + PG8_SB(b, h) + boff + n * 2048; \
        dst##8[n] = __builtin_shufflevector(*(const PG8_LAS i32x4_t*)p_, *(const PG8_LAS i32x4_t*)(p_ + 1024), 0, 1, 2, 3, 4, 5, 6, 7); } } \
    else { _Pragma("unroll") for (int n = 0; n < 2; ++n) _Pragma("unroll") for (int k = 0; k < 2; ++k) dst[n][k] = *(const PG8_LAS bf16x8*)(lds + PG8_SB(b, h) + boff + n * 2048 + k * 1024); } } while (0)
#define PG8_MMA(ai, bj, At, Bt) do { __builtin_amdgcn_s_setprio(1); _Pragma("unroll") for (int m = 0; m < 4; ++m) _Pragma("unroll") for (int n = 0; n < 2; ++n) { \
        if constexpr (FP8) { asm volatile("v_mfma_scale_f32_16x16x128_f8f6f4 %0, %1, %2, %0, %3, %3 op_sel_hi:[0,0,0]" : "+v"(acc[ai][bj][m][n]) : "v"(Bt##8[n]), "v"(At##8[m]), "v"(f8scale)); }     \
        else { _Pragma("unroll") for (int k = 0; k < 2; ++k) acc[ai][bj][m][n] = __builtin_amdgcn_mfma_f32_16x16x32_bf16(Bt[n][k], At[m][k], acc[ai][bj][m][n], 0, 0, 0); } } \
        __builtin_amdgcn_s_setprio(0); } while (0)
#define PG8_WAIT_V(n) asm volatile("s_waitcnt vmcnt(" #n ")" ::: "memory")
#define PG8_WAIT_L(n) asm volatile("s_waitcnt lgkmcnt(" #n ")" ::: "memory")
#define PG8_BAR __builtin_amdgcn_s_barrier()
#define PG8_SCHED __builtin_amdgcn_sched_barrier(0)
    Unit cur, nxt; int ui = 0;
    if (!S.next(0, cur)) return;
    f32x4 acc[2][2][4][2];
#pragma unroll
    for (int a = 0; a < 2; ++a)
#pragma unroll
        for (int b = 0; b < 2; ++b)
#pragma unroll
            for (int m = 0; m < 4; ++m)
#pragma unroll
                for (int n = 0; n < 2; ++n) acc[a][b][m][n] = (f32x4){0.f, 0.f, 0.f, 0.f};
    const int f8scale = 0x7F7F7F7F; (void)f8scale;
    bf16x8 At[4][2], B0[2][2], B1[2][2]; i32x8_t At8[4], B08[2], B18[2]; (void)At; (void)B0; (void)B1; (void)At8; (void)B08; (void)B18;
    const char* cA = (const char*)g.A + (size_t)cur.pm * tstepA; const char* cB = (const char*)g.Bt + (size_t)cur.pn * tstepB;
    S.a_ready(cur);
    if constexpr (SP2) {
        PG8_STAGE(PG8_SB(0, 0), cB, voffB); PG8_STAGE(PG8_SB(0, 1), cB + hstepB, voffB); PG8_STAGE(PG8_SA(0, 0), cA, voffA); PG8_STAGE(PG8_SA(0, 1), cA + hstepA, voffA);
        if (wr == 1) PG8_BAR;
        PG8_WAIT_V(2); PG8_BAR;
        PG8_STAGE(PG8_SB(1, 0), cB + kstep, voffB); PG8_STAGE(PG8_SA(1, 0), cA + kstep, voffA); PG8_STAGE(PG8_SB(1, 1), cB + hstepB + kstep, voffB);
        PG8_WAIT_V(6); PG8_BAR;
    } else {
        PG8_STAGE(PG8_SB(0, 0), cB, voffB); PG8_STAGE(PG8_SA(0, 0), cA, voffA); PG8_STAGE(PG8_SB(0, 1), cB + hstepB, voffB); PG8_STAGE(PG8_SA(0, 1), cA + hstepA, voffA);
        if (wr == 1) PG8_BAR;
        PG8_WAIT_V(4); PG8_BAR;
        PG8_STAGE(PG8_SB(1, 0), cB + kstep, voffB); PG8_STAGE(PG8_SA(1, 0), cA + kstep, voffA); PG8_STAGE(PG8_SB(1, 1), cB + hstepB + kstep, voffB);
        PG8_WAIT_V(6); PG8_BAR;
    }
    int prep_pm = -1, prep_buf = 0; (void)prep_pm; (void)prep_buf;
    for (;;) {
        if constexpr (Epi::HAS_PREP) { if (cur.pm != prep_pm) { prep_buf ^= 1; E.prepare(cur, tid, prep_buf); prep_pm = cur.pm; } }
        const bool has_next = S.next(ui + 1, nxt);
        const char* nA = has_next ? (const char*)g.A + (size_t)nxt.pm * tstepA : cA; const char* nB = has_next ? (const char*)g.Bt + (size_t)nxt.pn * tstepB : cB;
        for (int t = 0; t < nt; t += 2) {
            const bool last = (t == nt - 2);
            const char* a1 = cA + (size_t)(t + 1) * kstep;
            const char* a2 = last ? nA : cA + (size_t)(t + 2) * kstep; const char* b2 = last ? nB : cB + (size_t)(t + 2) * kstep;
            const char* a3 = a2 + kstep; const char* b3 = b2 + kstep;
            if (last && has_next) S.a_ready(nxt);
            if constexpr (SP2) {
            PG8_LDB(B0, 0, 0); PG8_LDB(B1, 0, 1); PG8_SCHED; PG8_LDA(At, 0, 0); PG8_STAGE(PG8_SA(1, 1), a1 + hstepA, voffA);
            PG8_WAIT_V(8); PG8_WAIT_L(0); PG8_BAR; PG8_MMA(0, 0, At, B0); PG8_MMA(0, 1, At, B1); PG8_BAR; PG8_SCHED;
            PG8_LDA(At, 0, 1); PG8_STAGE(PG8_SB(0, 0), b2, voffB); PG8_STAGE(PG8_SB(0, 1), b2 + hstepB, voffB); PG8_STAGE(PG8_SA(0, 0), a2, voffA);
            PG8_WAIT_V(8); PG8_WAIT_L(0); PG8_BAR; PG8_MMA(1, 0, At, B0); PG8_MMA(1, 1, At, B1); PG8_BAR; PG8_SCHED;
            PG8_LDB(B0, 1, 0); PG8_LDB(B1, 1, 1); PG8_SCHED; PG8_LDA(At, 1, 0); PG8_STAGE(PG8_SA(0, 1), a2 + hstepA, voffA);
            PG8_WAIT_V(8); PG8_WAIT_L(0); PG8_BAR; PG8_MMA(0, 0, At, B0); PG8_MMA(0, 1, At, B1); PG8_BAR; PG8_SCHED;
            PG8_LDA(At, 1, 1); PG8_STAGE(PG8_SB(1, 0), b3, voffB); PG8_STAGE(PG8_SB(1, 1), b3 + hstepB, voffB); PG8_STAGE(PG8_SA(1, 0), a3, voffA);
            PG8_WAIT_V(8); PG8_WAIT_L(0); PG8_BAR; PG8_MMA(1, 0, At, B0); PG8_MMA(1, 1, At, B1); PG8_BAR; PG8_SCHED;
            } else {
            PG8_LDB(B0, 0, 0); PG8_SCHED; PG8_LDA(At, 0, 0); PG8_STAGE(PG8_SA(1, 1), a1 + hstepA, voffA);
            PG8_WAIT_L(8); PG8_BAR; PG8_WAIT_L(0); PG8_MMA(0, 0, At, B0); PG8_BAR; PG8_SCHED;
            PG8_LDB(B1, 0, 1); PG8_STAGE(PG8_SB(0, 0), b2, voffB);
            PG8_BAR; PG8_WAIT_L(0); PG8_MMA(0, 1, At, B1); PG8_BAR;
            PG8_LDA(At, 0, 1); PG8_STAGE(PG8_SA(0, 0), a2, voffA);
            PG8_BAR; PG8_WAIT_L(0); PG8_MMA(1, 0, At, B0); PG8_BAR; PG8_SCHED;
            PG8_STAGE(PG8_SB(0, 1), b2 + hstepB, voffB);
            PG8_WAIT_V(6); PG8_BAR; PG8_MMA(1, 1, At, B1); PG8_BAR;
            PG8_LDB(B0, 1, 0); PG8_SCHED; PG8_LDA(At, 1, 0); PG8_STAGE(PG8_SA(0, 1), a2 + hstepA, voffA);
            PG8_WAIT_L(8); PG8_BAR; PG8_WAIT_L(0); PG8_MMA(0, 0, At, B0); PG8_BAR; PG8_SCHED;
            PG8_LDB(B1, 1, 1); PG8_STAGE(PG8_SB(1, 0), b3, voffB);
            PG8_BAR; PG8_WAIT_L(0); PG8_MMA(0, 1, At, B1); PG8_BAR;
            PG8_LDA(At, 1, 1); PG8_STAGE(PG8_SA(1, 0), a3, voffA);
            PG8_BAR; PG8_WAIT_L(0); PG8_MMA(1, 0, At, B0); PG8_BAR; PG8_SCHED;
            PG8_STAGE(PG8_SB(1, 1), b3 + hstepB, voffB);
            PG8_WAIT_V(6); PG8_BAR; PG8_MMA(1, 1, At, B1); PG8_BAR;
            }
        }
        if constexpr (ALIGN_EPI) { if (wr == 0) PG8_BAR; }
        if constexpr (FP8) { asm volatile("s_nop 15\n\ts_nop 15\n\ts_nop 7" ::: "memory"); }
        if constexpr (!Epi::AFTER_DRAIN) { if constexpr (Epi::HAS_PREP) E(acc, cur, wr, wc, fr, fq, prep_buf); else E(acc, cur, wr, wc, fr, fq); S.done(cur); }
        if (!has_next) break;
#pragma unroll
        for (int a = 0; a < 2; ++a)
#pragma unroll
            for (int b = 0; b < 2; ++b)
#pragma unroll
                for (int m = 0; m < 4; ++m)
#pragma unroll
                    for (int n = 0; n < 2; ++n) acc[a][b][m][n] = (f32x4){0.f, 0.f, 0.f, 0.f};
        cur = nxt; cA = nA; cB = nB; ++ui;
        if constexpr (ALIGN_EPI) { if (wr == 1) PG8_BAR; }
    }
    PG8_WAIT_V(0);
    if constexpr (!ALIGN_EPI) { if (wr == 0) PG8_BAR; }
    PG8_BAR;
    if constexpr (Epi::AFTER_DRAIN) { E.fused(acc, cur, wr, wc, fr, fq, lds, wid, lane); S.done(cur); }
#undef PG8_SA
#undef PG8_SB
#undef PG8_STAGE
#undef PG8_LDA
#undef PG8_LDB
#undef PG8_MMA
#undef PG8_WAIT_V
#undef PG8_WAIT_L
#undef PG8_BAR
#undef PG8_SCHED
}
}
typedef GAS unsigned gu32;
#define RLX_AGENT __ATOMIC_RELAXED, __HIP_MEMORY_SCOPE_AGENT
#define XB_TMO      128
#define XB_XCNT(j)  (256  + 64 * (j))
#define XB_XSUB(j)  (1280 + 64 * (j))
#define XB_XGEN(j)  (2304 + 64 * (j))
#define XB_TOP      3328
#define XB_TOPGEN   3392
#define XCD_BAR_WORDS 3456
#define XB_SPIN_CAP (1u << 18)

__device__ __forceinline__ unsigned xb_ld(unsigned* p)              { return __hip_atomic_load(p, __ATOMIC_RELAXED, __HIP_MEMORY_SCOPE_AGENT); }
__device__ __forceinline__ unsigned xb_add(unsigned* p, unsigned v) { return __hip_atomic_fetch_add(p, v, __ATOMIC_RELAXED, __HIP_MEMORY_SCOPE_AGENT); }
__device__ __forceinline__ unsigned xb_xcc_id() { return (unsigned)__builtin_amdgcn_s_getreg((3 << 11) | 20) & 0xFu; }
#define XB_SPIN(cond, bar) do { unsigned _sp = 0; while (cond) { __builtin_amdgcn_s_sleep(1); \
    if ((++_sp & 255u) == 0u) { if (xb_ld(&(bar)[XB_TMO])) break; if (_sp > XB_SPIN_CAP) { atomicAdd(&(bar)[XB_TMO], 1u); break; } } } } while (0)

struct XcdBarrier {
    unsigned* bar; unsigned x;
    volatile LAS unsigned* st;
};

__device__ __forceinline__ XcdBarrier xcd_barrier_post(unsigned* bar, volatile LAS unsigned* st) {
    XcdBarrier b; b.bar = bar; b.x = xb_xcc_id(); b.st = st;
    if (threadIdx.x == 0) (void)xb_add(&bar[XB_XCNT(b.x)], 1u);
    return b;
}
__device__ __forceinline__ void xcd_barrier_complete(unsigned* bar, unsigned x, unsigned& nloc, unsigned& nx) {
    const unsigned G = gridDim.x * gridDim.y * gridDim.z;
    unsigned sum, cnt, mine, sp = 0u;
    for (;;) {
        sum = 0u; cnt = 0u; mine = 0u;
#pragma unroll
        for (unsigned j = 0; j < 16; ++j) { const unsigned c = xb_ld(&bar[XB_XCNT(j)]); sum += c; cnt += (c > 0u) ? 1u : 0u; mine = (j == x) ? c : mine; }
        if (sum == G) break;
        __builtin_amdgcn_s_sleep(1);
        if ((++sp & 255u) == 0u) { if (xb_ld(&bar[XB_TMO])) break; if (sp > XB_SPIN_CAP) { atomicAdd(&bar[XB_TMO], 1u); break; } }
    }
    nloc = mine > 0u ? mine : 1u; nx = cnt > 0u ? cnt : 1u;
}

__device__ __forceinline__ void xcd_barrier(const XcdBarrier& b) {
    asm volatile("s_waitcnt vmcnt(0)" ::: "memory");
    __syncthreads();
    if (threadIdx.x == 0) {
        unsigned* bar = b.bar;
        __builtin_amdgcn_s_waitcnt(0);
        unsigned nloc = b.st[0], nx = b.st[1];
        if (nloc == 0u) { xcd_barrier_complete(bar, b.x, nloc, nx); b.st[0] = nloc; b.st[1] = nx; }
        const unsigned old = xb_add(&bar[XB_XSUB(b.x)], 1u);
        const unsigned gen = old / nloc;
        if (old + 1u == (gen + 1u) * nloc) {
            __builtin_amdgcn_fence(__ATOMIC_RELEASE, "agent");
            asm volatile("s_waitcnt vmcnt(0)" ::: "memory");
            const unsigned og = xb_add(&bar[XB_TOP], 1u);
            const unsigned tg = og / nx;
            if (og + 1u == (tg + 1u) * nx) xb_add(&bar[XB_TOPGEN], 1u);
            else XB_SPIN(xb_ld(&bar[XB_TOPGEN]) == tg, bar);
            __builtin_amdgcn_fence(__ATOMIC_ACQUIRE, "agent");
            xb_add(&bar[XB_XGEN(b.x)], 1u);
            asm volatile("s_waitcnt vmcnt(0)" ::: "memory");
        } else {
            XB_SPIN(xb_ld(&bar[XB_XGEN(b.x)]) == gen, bar);
            __builtin_amdgcn_fence(__ATOMIC_ACQUIRE, "agent");
            asm volatile("s_waitcnt vmcnt(0)" ::: "memory");
        }
    }
    __syncthreads();
}
namespace pg8 {
__device__ __forceinline__ float sum16(const float* p) {
    const f32x4* sp = (const f32x4*)p; f32x4 a = sp[0] + sp[1]; const f32x4 b = sp[2] + sp[3]; a = a + b; return (a[0] + a[1]) + (a[2] + a[3]);
}
__device__ __forceinline__ float row_rs(const float* statx, int row) { return __builtin_amdgcn_rsqf(sum16(statx + (size_t)row * 16) * (1.0f / 1024.0f) + EPS); }

constexpr int RS_TAB_OFF = 131072 + 1024;
__device__ __forceinline__ void rs_prepare(PG8_LAS float* tab, const float* rstat, int pitch, int slot0, int n, float invdim, int row0, int tid) {
    const int r = tid >> 1, h = tid & 1; const float* rp = rstat + (size_t)(row0 + r) * pitch + slot0; float s = 0.f;
    for (int c = h; 4 * c < n; c += 2) { const f32x4 t = *(const f32x4*)(rp + 4 * c); s += (t[0] + t[1]) + (t[2] + t[3]); }
    s += __shfl_xor(s, 1);
    if (h == 0) tab[r] = __builtin_amdgcn_rsqf(s * invdim + EPS);
}
template <bool F8> struct EpiSwiGLU {
    static constexpr bool PERM = true, AFTER_DRAIN = false, HAS_PREP = true;
    unsigned char* O; const float* statx; PG8_LAS float* tab; float ascale;
    __device__ __forceinline__ void prepare(const Unit& u, int tid, int buf) const { rs_prepare(tab + 256 * buf, statx, 16, 0, 16, 1.0f / 1024.0f, u.pm * BM, tid); }
    __device__ __forceinline__ void operator()(const f32x4 (&acc)[2][2][4][2], const Unit& u, int wr, int wc, int fr, int fq, int buf) const {
        const int row0 = u.pm * BM + wr * 64 + fr, col0 = u.pn * HALF + wc * 32 + 8 * fq;
        const PG8_LAS float* tp = tab + 256 * buf + wr * 64 + fr; float rsv[2][4];
#pragma unroll
        for (int ai = 0; ai < 2; ++ai)
#pragma unroll
            for (int m = 0; m < 4; ++m) rsv[ai][m] = tp[ai * HALF + m * 16] * ascale;
#pragma unroll
        for (int ai = 0; ai < 2; ++ai)
#pragma unroll
            for (int m = 0; m < 4; ++m) {
                int row = row0 + ai * HALF + m * 16; asm volatile("" : "+v"(row)); const float rs = rsv[ai][m];
                float o[8];
#pragma unroll
                for (int n = 0; n < 2; ++n)
#pragma unroll
                    for (int e = 0; e < 4; ++e) { const float g = acc[ai][0][m][n][e] * rs, uu = acc[ai][1][m][n][e] * rs;
                        o[4 * n + e] = g * uu * __builtin_amdgcn_rcpf(1.0f + __builtin_amdgcn_exp2f(-LOG2E * g)); }
                if constexpr (F8) {
#pragma unroll
                for (int e = 0; e < 8; ++e) o[e] = __builtin_fminf(__builtin_fmaxf(o[e] * ACT_F8_SCALE, -448.0f), 448.0f);
                int w0 = 0, w1 = 0;
                w0 = __builtin_amdgcn_cvt_pk_fp8_f32(o[0], o[1], w0, false); w0 = __builtin_amdgcn_cvt_pk_fp8_f32(o[2], o[3], w0, true);
                w1 = __builtin_amdgcn_cvt_pk_fp8_f32(o[4], o[5], w1, false); w1 = __builtin_amdgcn_cvt_pk_fp8_f32(o[6], o[7], w1, true);
                *(u32x2*)(O + (size_t)row * FF + col0) = (u32x2){(unsigned)w0, (unsigned)w1};
                } else {
                    u32x4 w; w.x = cvt_pk_bf16(o[0], o[1]); w.y = cvt_pk_bf16(o[2], o[3]); w.z = cvt_pk_bf16(o[4], o[5]); w.w = cvt_pk_bf16(o[6], o[7]);
                    *(u32x4*)((bf16_t*)O + (size_t)row * FF + col0) = w;
                }
            }
    }
};
struct EpiResid {
    static constexpr bool PERM = true, AFTER_DRAIN = false, HAS_PREP = false;
    bf16_t* xb; float* statx; float alpha; unsigned char* xb8 = nullptr;
    __device__ __forceinline__ void operator()(const f32x4 (&acc)[2][2][4][2], const Unit& u, int wr, int wc, int fr_, int fq_) const {
        int fr = fr_, fq = fq_; asm volatile("" : "+v"(fr), "+v"(fq));
        const int row0 = u.pm * BM + wr * 64 + fr, col0 = u.pn * BM + wc * 32 + 8 * fq;
        u32x4 xv[8][2];
#pragma unroll
        for (int idx = 0; idx < 8; ++idx) { const int row = row0 + (idx >> 2) * HALF + (idx & 3) * 16; const size_t off = (size_t)row * DM + col0;
            xv[idx][0] = *(const u32x4*)(xb + off); xv[idx][1] = *(const u32x4*)(xb + off + HALF); }
#pragma unroll
        for (int idx = 0; idx < 8; ++idx) {
            const int ai = idx >> 2, m = idx & 3;
            int row = row0 + ai * HALF + m * 16; asm volatile("" : "+v"(row)); const size_t off = (size_t)row * DM + col0; float ss = 0.f;
#pragma unroll
            for (int bj = 0; bj < 2; ++bj) {
                const u32x4 b = xv[idx][bj];
                float v[8];
#pragma unroll
                for (int e = 0; e < 4; ++e) { v[2 * e] = __builtin_bit_cast(float, b[e] << 16) + acc[ai][bj][m][e >> 1][2 * (e & 1)] * alpha;
                                              v[2 * e + 1] = __builtin_bit_cast(float, b[e] & 0xFFFF0000u) + acc[ai][bj][m][e >> 1][2 * (e & 1) + 1] * alpha; }
                u32x4 w; w.x = cvt_pk_bf16(v[0], v[1]); w.y = cvt_pk_bf16(v[2], v[3]); w.z = cvt_pk_bf16(v[4], v[5]); w.w = cvt_pk_bf16(v[6], v[7]);
                *(u32x4*)(xb + off + bj * HALF) = w;
                if (xb8) { float q[8];
#pragma unroll
                    for (int e = 0; e < 8; ++e) q[e] = __builtin_fminf(__builtin_fmaxf(v[e] * X_F8_SCALE, -448.0f), 448.0f);
                    int w0 = 0, w1 = 0; w0 = __builtin_amdgcn_cvt_pk_fp8_f32(q[0], q[1], w0, false); w0 = __builtin_amdgcn_cvt_pk_fp8_f32(q[2], q[3], w0, true);
                    w1 = __builtin_amdgcn_cvt_pk_fp8_f32(q[4], q[5], w1, false); w1 = __builtin_amdgcn_cvt_pk_fp8_f32(q[6], q[7], w1, true);
                    *(u32x2*)(xb8 + off + bj * HALF) = (u32x2){(unsigned)w0, (unsigned)w1}; }
#pragma unroll
                for (int e = 0; e < 8; ++e) ss += v[e] * v[e];
            }
            ss += __shfl_xor(ss, 16); ss += __shfl_xor(ss, 32);
            if (fq == 0) statx[(size_t)row * 16 + u.pn * 4 + wc] = ss;
            asm volatile("" ::: "memory");
        }
    }
};
template <bool STATS> struct EpiScatter {
    static constexpr bool PERM = true, AFTER_DRAIN = false, HAS_PREP = true;
    const Desc* tab; unsigned char* ws; const float* rstat; int rs_pitch, rs_slot0, rs_n; float rs_invdim; float* statc; PG8_LAS float* rtab; int pn0 = 0; float ascale = 1.0f;
    __device__ __forceinline__ void prepare(const Unit& u, int tid, int buf) const { rs_prepare(rtab + 256 * buf, rstat, rs_pitch, rs_slot0, rs_n, rs_invdim, u.pm * BM, tid); }
    __device__ __forceinline__ float scale_of(int id) const { return id == 0 ? 1.0f : (id == 1 ? C2_64 : C2_96); }
    __device__ __forceinline__ void store8(int buf, int col, int row, bool asf32, const float (&v)[8]) const {
        if (buf < 0) return;
        unsigned char* p = ws + BUF_OFF[buf];
        const size_t idx = (size_t)row * BUF_PITCH[buf] + col;
        if (asf32) { float* q = (float*)p + idx; *(f32x4*)q = (f32x4){v[0], v[1], v[2], v[3]}; *(f32x4*)(q + 4) = (f32x4){v[4], v[5], v[6], v[7]}; }
        else { u32x4 w; w.x = cvt_pk_bf16(v[0], v[1]); w.y = cvt_pk_bf16(v[2], v[3]); w.z = cvt_pk_bf16(v[4], v[5]); w.w = cvt_pk_bf16(v[6], v[7]); *(u32x4*)((bf16_t*)p + idx) = w; }
    }
    __device__ __forceinline__ void operator()(const f32x4 (&acc)[2][2][4][2], const Unit& u, int wr, int wc, int fr, int fq, int buf) const {
        const PG8_LAS float* tp = rtab + 256 * buf + wr * 64 + fr; float rsv[2][4];
#pragma unroll
        for (int ai = 0; ai < 2; ++ai)
#pragma unroll
            for (int m = 0; m < 4; ++m) rsv[ai][m] = tp[ai * HALF + m * 16] * ascale;
        const Desc d = tab[(u.pn + pn0) * 8 + 2 * wc + (fq >> 1)];
        const int sub = (fq & 1) * 8;
        const float sc0 = scale_of(d.scale0), sc1 = scale_of(d.scale1);
        const int row0 = u.pm * BM + wr * 64 + fr;
        const bool v0 = d.buf0 >= 0, v1 = d.buf1 >= 0;
        unsigned char* const p0 = ws + (v0 ? BUF_OFF[d.buf0] : 0ull) + (size_t)(d.col0 + sub) * 2;
        unsigned char* const p1 = ws + (v1 ? BUF_OFF[d.buf1] : 0ull) + (size_t)(d.col1 + sub) * 2;
        const size_t pb0 = (size_t)(v0 ? BUF_PITCH[d.buf0] : 0) * 2, pb1 = (size_t)(v1 ? BUF_PITCH[d.buf1] : 0) * 2;
        if (STATS) {
            const int st0 = __builtin_amdgcn_readfirstlane((int)d.stat0), st1 = __builtin_amdgcn_readfirstlane((int)d.stat1);
            if (st0 >= 0 || st1 >= 0) {
#pragma unroll
                for (int ai = 0; ai < 2; ++ai)
#pragma unroll
                    for (int m = 0; m < 4; ++m) {
                        int row = row0 + ai * HALF + m * 16; asm volatile("" : "+v"(row));
                        const float rs = rsv[ai][m]; float s0 = 0.f, s1 = 0.f;
#pragma unroll
                        for (int n = 0; n < 2; ++n)
#pragma unroll
                            for (int e = 0; e < 4; ++e) { const float x = acc[ai][0][m][n][e] * rs, y = acc[ai][1][m][n][e] * rs; s0 += x * x; s1 += y * y; }
                        s0 += __shfl_xor(s0, 16); s0 += __shfl_xor(s0, 32); s1 += __shfl_xor(s1, 16); s1 += __shfl_xor(s1, 32);
                        if (fq == 0 && st0 >= 0) statc[(size_t)row * 32 + st0 + wc] = s0;
                        if (fq == 0 && st1 >= 0) statc[(size_t)row * 32 + st1 + wc] = s1;
                        asm volatile("" ::: "memory");
                    }
            }
        }
        const int ropeid = d.rope; const int jsub = d.j0 + sub;
        f32x4 csn[4] = {};
#define EPI_ROPE_LOAD(dst, rw) do { const int pos_ = (rw) & (SEQ - 1); \
            const float* tp_ = (ropeid == 1) ? (const float*)(ws + WS_TAB64) + ((size_t)pos_ * 32 + jsub) * 2 : (const float*)(ws + WS_TAB32) + ((size_t)pos_ * 16 + jsub) * 2; \
            _Pragma("unroll") for (int i_ = 0; i_ < 4; ++i_) dst[i_] = *(const f32x4*)(tp_ + 4 * i_); } while (0)
        if (ropeid) { int r0_ = row0; asm volatile("" : "+v"(r0_)); EPI_ROPE_LOAD(csn, r0_); }
#pragma unroll
        for (int idx = 0; idx < 8; ++idx) {
                const int ai = idx >> 2, m = idx & 3;
                int row = row0 + ai * HALF + m * 16; asm volatile("" : "+v"(row));
                const float rs = rsv[ai][m];
                float a[8], b[8];
#pragma unroll
                for (int n = 0; n < 2; ++n)
#pragma unroll
                    for (int e = 0; e < 4; ++e) { a[4 * n + e] = acc[ai][0][m][n][e] * rs; b[4 * n + e] = acc[ai][1][m][n][e] * rs; }
                if (ropeid) {
                    f32x4 cs[4];
#pragma unroll
                    for (int i = 0; i < 4; ++i) cs[i] = csn[i];
                    if (idx < 7) { int rn_ = row0 + ((idx + 1) >> 2) * HALF + ((idx + 1) & 3) * 16; asm volatile("" : "+v"(rn_)); EPI_ROPE_LOAD(csn, rn_); }
#pragma unroll
                    for (int e = 0; e < 8; ++e) { const float c = cs[e >> 1][2 * (e & 1)], s = cs[e >> 1][2 * (e & 1) + 1]; const float x1 = a[e], x2 = b[e]; a[e] = x1 * c - x2 * s; b[e] = x1 * s + x2 * c; }
                }
#pragma unroll
                for (int e = 0; e < 8; ++e) { a[e] *= sc0; b[e] *= sc1; }
                if (v0) { u32x4 w; w.x = cvt_pk_bf16(a[0], a[1]); w.y = cvt_pk_bf16(a[2], a[3]); w.z = cvt_pk_bf16(a[4], a[5]); w.w = cvt_pk_bf16(a[6], a[7]); *(u32x4*)(p0 + (size_t)row * pb0) = w; }
                if (v1) { u32x4 w; w.x = cvt_pk_bf16(b[0], b[1]); w.y = cvt_pk_bf16(b[2], b[3]); w.z = cvt_pk_bf16(b[4], b[5]); w.w = cvt_pk_bf16(b[6], b[7]); *(u32x4*)(p1 + (size_t)row * pb1) = w; }
                asm volatile("" ::: "memory");
        }
#undef EPI_ROPE_LOAD
    }
};
}
constexpr int RING_OFF = 0, RING_BYTES = 131072;
constexpr int LDSCTL_OFF = RING_BYTES, MISC_OFF = LDSCTL_OFF + 320;
constexpr int LDS_BYTES = 147456;
#define LDS_WAIT() asm volatile("s_waitcnt lgkmcnt(0)" ::: "memory")
#define VM_WAIT() asm volatile("s_waitcnt vmcnt(0)" ::: "memory")
__device__ __forceinline__ unsigned f2bf(float f) { unsigned u = __builtin_bit_cast(unsigned, f); return (u + 0x7fffu + ((u >> 16) & 1u)) >> 16; }
__device__ __forceinline__ unsigned pk2(float lo, float hi) { return f2bf(lo) | (f2bf(hi) << 16); }
__device__ __forceinline__ float wave_sum(float v) {
#pragma unroll
    for (int o = 1; o < 64; o <<= 1) v += __shfl_xor(v, o);
    return v;
}

template <class T> __device__ __forceinline__ T* opaque_global(T* p) { GAS T* g = (GAS T*)p; asm volatile("" : "+s"(g)); return (T*)g; }
struct Frame {
    LAS unsigned char* lds;
    volatile LAS unsigned* MISC;
    gu32* ctl;
    unsigned char* ws;
    int wave, vcu, G;
};

template <int MODE>
__device__ __forceinline__ void conv_item(const float* W0, const float* W1, const short* map, const float* gain, int K, int Nsrc, bf16_t* WT, LAS float* scr, int item, int nblk, int lane) {
    const int kb = item / nblk, nb = item % nblk, k0 = 64 * kb, n0 = 32 * nb;
    const int n = n0 + (lane & 31);
    const float* W = W0; int col = n;
    if (MODE == 1) { col = (n >> 8) * 128 + (n & 127); W = ((n >> 7) & 1) ? W1 : W0; }
    if (MODE == 2) col = map[n];
    float wv[32];
    const float* wp = W + (size_t)(k0 + (lane >> 5)) * Nsrc + (col >= 0 ? col : 0);
    const int c = lane & 7;
    f32x4 g0 = {1.f, 1.f, 1.f, 1.f}, g1 = {1.f, 1.f, 1.f, 1.f};
    if (gain) { const f32x4* gp = (const f32x4*)(gain + k0 + 8 * c); g0 = gp[0]; g1 = gp[1]; }
#pragma unroll
    for (int i = 0; i < 32; ++i) wv[i] = wp[(size_t)(2 * i) * Nsrc];
#pragma unroll
    for (int i = 0; i < 32; ++i) { const int kk = 2 * i + (lane >> 5); const float v = (col >= 0) ? wv[i] : 0.f; scr[kk * 33 + (lane & 31)] = v; }
    LDS_WAIT(); asm volatile("" ::: "memory");
#pragma unroll
    for (int j = 0; j < 4; ++j) { const int nn = (lane >> 3) + 8 * j; const LAS float* s = scr + (8 * c) * 33 + nn;
        u32x4 o; o.x = pk2(s[0 * 33] * g0[0], s[1 * 33] * g0[1]); o.y = pk2(s[2 * 33] * g0[2], s[3 * 33] * g0[3]); o.z = pk2(s[4 * 33] * g1[0], s[5 * 33] * g1[1]); o.w = pk2(s[6 * 33] * g1[2], s[7 * 33] * g1[3]);
        *(GAS u32x4*)(WT + (size_t)(n0 + nn) * K + k0 + 8 * c) = o; }
    LDS_WAIT(); asm volatile("" ::: "memory");
}
template <int MODE = 0>
__device__ __forceinline__ void conv_item_f8(const float* W0, int K, int Nsrc, unsigned char* WT8, LAS float* scr, int item, int nblk, int lane, float scale, const float* W1 = nullptr, const float* gain = nullptr, const short* map = nullptr) {
    const int kb = item / nblk, nb = item % nblk, k0 = 64 * kb, n0 = 32 * nb;
    const int n = n0 + (lane & 31);
    const float* W = W0; int col = n;
    if (MODE == 1) { col = (n >> 8) * 128 + (n & 127); W = ((n >> 7) & 1) ? W1 : W0; }
    if (MODE == 2) col = map[n];
    float wv[32];
    const float* wp = W + (size_t)(k0 + (lane >> 5)) * Nsrc + (col >= 0 ? col : 0);
    const int c = lane & 7;
    f32x4 g0 = {1.f, 1.f, 1.f, 1.f}, g1 = {1.f, 1.f, 1.f, 1.f};
    if (gain) { const f32x4* gp = (const f32x4*)(gain + k0 + 8 * c); g0 = gp[0]; g1 = gp[1]; }
#pragma unroll
    for (int i = 0; i < 32; ++i) wv[i] = wp[(size_t)(2 * i) * Nsrc];
#pragma unroll
    for (int i = 0; i < 32; ++i) { const int kk = 2 * i + (lane >> 5); scr[kk * 33 + (lane & 31)] = (col >= 0) ? wv[i] : 0.f; }
    LDS_WAIT(); asm volatile("" ::: "memory");
#pragma unroll
    for (int j = 0; j < 4; ++j) { const int nn = (lane >> 3) + 8 * j; const LAS float* s = scr + (8 * c) * 33 + nn; float v[8];
#pragma unroll
        for (int e = 0; e < 8; ++e) v[e] = __builtin_fminf(__builtin_fmaxf(s[e * 33] * (e < 4 ? g0[e & 3] : g1[e & 3]) * scale, -448.0f), 448.0f);
        int w0 = 0, w1 = 0;
        w0 = __builtin_amdgcn_cvt_pk_fp8_f32(v[0], v[1], w0, false); w0 = __builtin_amdgcn_cvt_pk_fp8_f32(v[2], v[3], w0, true);
        w1 = __builtin_amdgcn_cvt_pk_fp8_f32(v[4], v[5], w1, false); w1 = __builtin_amdgcn_cvt_pk_fp8_f32(v[6], v[7], w1, true);
        *(GAS u32x2*)(WT8 + (size_t)(n0 + nn) * K + k0 + 8 * c) = (u32x2){(unsigned)w0, (unsigned)w1}; }
    LDS_WAIT(); asm volatile("" ::: "memory");
}
struct In { const float* p[18]; };
__device__ __forceinline__ void p0_prologue(Frame& F, const In& in) {
    int tid_ = threadIdx.x; asm volatile("" : "+v"(tid_)); const int tid = tid_, lane = tid & 63;
    LAS float* scr = (LAS float*)(F.lds + RING_OFF + F.wave * 16384);
    const int gw = F.vcu * NWAVES + F.wave, NGW = F.G * NWAVES;
    constexpr int I_GU = 16 * 176, I_D = 44 * 32, I_IN = 16 * (NIN / 32), I_IW = 16, I_UQ = 6 * 16, I_UKV = 4 * 24, I_O = 16 * 32;
    constexpr int PER_LAYER = 2 * (I_GU + I_D) + I_IN + I_IW + I_UQ + I_UKV + I_O;
    for (int it = gw; it < DEPTH * PER_LAYER; it += NGW) {
        const int l = it / PER_LAYER; int r = it % PER_LAYER;
        unsigned char* wl = F.ws + WS_W + (size_t)l * W_LAYER;
        if (r < I_GU) { if (gu_is_f8(l, 0)) conv_item_f8<1>(in.p[2] + (size_t)l * DM * FF, DM, FF, wl + W_GU1, scr, r, 176, lane, WGU_F8_SCALE, in.p[3] + (size_t)l * DM * FF, in.p[1] + l * DM);
                        else conv_item<1>(in.p[2] + (size_t)l * DM * FF, in.p[3] + (size_t)l * DM * FF, nullptr, in.p[1] + l * DM, DM, FF, (bf16_t*)(wl + W_GU1), scr, r, 176, lane); continue; } r -= I_GU;
        if (r < I_GU) { if (gu_is_f8(l, 1)) conv_item_f8<1>(in.p[14] + (size_t)l * DM * FF, DM, FF, wl + W_GU2, scr, r, 176, lane, WGU_F8_SCALE, in.p[15] + (size_t)l * DM * FF, in.p[13] + l * DM);
                        else conv_item<1>(in.p[14] + (size_t)l * DM * FF, in.p[15] + (size_t)l * DM * FF, nullptr, in.p[13] + l * DM, DM, FF, (bf16_t*)(wl + W_GU2), scr, r, 176, lane); continue; } r -= I_GU;
        if (r < I_D) { if (d_is_f8(l, 0)) conv_item_f8(in.p[4] + (size_t)l * FF * DM, FF, DM, wl + W_D1, scr, r, 32, lane, WD_F8_SCALE);
                       else conv_item<0>(in.p[4] + (size_t)l * FF * DM, nullptr, nullptr, nullptr, FF, DM, (bf16_t*)(wl + W_D1), scr, r, 32, lane); continue; } r -= I_D;
        if (r < I_D) { if (d_is_f8(l, 1)) conv_item_f8(in.p[16] + (size_t)l * FF * DM, FF, DM, wl + W_D2, scr, r, 32, lane, WD_F8_SCALE);
                       else conv_item<0>(in.p[16] + (size_t)l * FF * DM, nullptr, nullptr, nullptr, FF, DM, (bf16_t*)(wl + W_D2), scr, r, 32, lane); continue; } r -= I_D;
        if (r < I_IN) { if (win_is_f8(l) && (r % (NIN / 32)) < WIN_F8_TILES * 8) conv_item_f8<2>(in.p[6] + (size_t)l * DM * 3080, DM, 3080, wl + W_IN, scr, r, NIN / 32, lane, WIN_F8_SCALE, nullptr, in.p[5] + l * DM, WIN_SRC);
                        else conv_item<2>(in.p[6] + (size_t)l * DM * 3080, nullptr, WIN_SRC, in.p[5] + l * DM, DM, 3080, (bf16_t*)(wl + W_IN), scr, r, NIN / 32, lane); continue; } r -= I_IN;
        if (r < I_IW) { conv_item<2>(in.p[6] + (size_t)l * DM * 3080, nullptr, WIW_SRC, in.p[5] + l * DM, DM, 3080, (bf16_t*)(wl + W_IW), scr, r, 1, lane); continue; } r -= I_IW;
        if (r < I_UQ) { conv_item<2>(in.p[10] + (size_t)l * 384 * 480, nullptr, WUQ_SRC, in.p[8] + l * 384, 384, 480, (bf16_t*)(wl + W_UQ), scr, r, 16, lane); continue; } r -= I_UQ;
        if (r < I_UKV) { conv_item<2>(in.p[11] + (size_t)l * 256 * 640, nullptr, WUKV_SRC, in.p[9] + l * 256, 256, 640, (bf16_t*)(wl + W_UKV), scr, r, 24, lane); continue; } r -= I_UKV;
        if (wo_is_f8(l)) conv_item_f8(in.p[12] + (size_t)l * DM * DM, DM, DM, wl + W_OUT, scr, r, 32, lane, WO_F8_SCALE);
        else conv_item<0>(in.p[12] + (size_t)l * DM * DM, nullptr, nullptr, nullptr, DM, DM, (bf16_t*)(wl + W_OUT), scr, r, 32, lane);
    }
    { const int gt = F.vcu * (NWAVES * 64) + tid, NGT = F.G * NWAVES * 64;
      for (int e = gt; e < SEQ * 48; e += NGT) {
          int pos, j; double inv; float* dst;
          if (e < SEQ * 32) { pos = e >> 5; j = e & 31; inv = INV64[j]; dst = (float*)(F.ws + WS_TAB64) + (size_t)e * 2; }
          else { const int e2 = e - SEQ * 32; pos = e2 >> 4; j = e2 & 15; inv = INV32[j]; dst = (float*)(F.ws + WS_TAB32) + (size_t)e2 * 2; }
          double rv = (double)pos * inv * 0.15915494309189535; rv -= __builtin_rint(rv);
          const float rf = (float)rv;
          *(f32x2*)dst = (f32x2){__builtin_amdgcn_cosf(rf), __builtin_amdgcn_sinf(rf)};
      } }
    const float* x = in.p[0]; bf16_t* xb = (bf16_t*)(F.ws + WS_XB); float* statx = (float*)(F.ws + WS_STATX);
    for (int m0 = 2 * gw; m0 < M; m0 += 2 * NGW) {
        f32x4 v[2][4];
#pragma unroll
        for (int r = 0; r < 2; ++r) { const GAS f32x4* xr = (const GAS f32x4*)(x + (size_t)(m0 + r) * DM) + lane;
#pragma unroll
            for (int j = 0; j < 4; ++j) v[r][j] = xr[64 * j]; }
#pragma unroll
        for (int r = 0; r < 2; ++r) { GAS unsigned long long* o8 = (GAS unsigned long long*)(xb + (size_t)(m0 + r) * DM) + lane; float s = 0.f;
#pragma unroll
            for (int j = 0; j < 4; ++j) { const f32x4 t = v[r][j]; s += (t.x * t.x + t.y * t.y) + (t.z * t.z + t.w * t.w);
                o8[64 * j] = (unsigned long long)pk2(t.x, t.y) | ((unsigned long long)pk2(t.z, t.w) << 32); }
            s = wave_sum(s);
            if (lane < 16) statx[(size_t)(m0 + r) * 16 + lane] = (lane == 0) ? s : 0.f; }
    }
}
__device__ __forceinline__ void final_norm(Frame& F, float* out, const float* g) {
    int tid_ = threadIdx.x; asm volatile("" : "+v"(tid_)); const int lane = tid_ & 63;
    const int gw = F.vcu * NWAVES + F.wave, NGW = F.G * NWAVES; const float* statx = (const float*)(F.ws + WS_STATX); const bf16_t* xb = (const bf16_t*)(F.ws + WS_XB);
    f32x4 gv[4];
#pragma unroll
    for (int j = 0; j < 4; ++j) gv[j] = *((const f32x4*)g + lane + 64 * j);
    for (int m = gw; m < M; m += 2 * NGW) {
        float rs[2]; u32x2 b[2][4];
#pragma unroll
        for (int r = 0; r < 2; ++r) { const int mr = (m + r * NGW < M) ? m + r * NGW : m; rs[r] = pg8::row_rs(statx, mr);
            const GAS u32x2* xr = (const GAS u32x2*)(xb + (size_t)mr * DM) + lane;
#pragma unroll
            for (int j = 0; j < 4; ++j) b[r][j] = xr[64 * j]; }
#pragma unroll
        for (int r = 0; r < 2; ++r) { if (m + r * NGW >= M) break; GAS f32x4* orow = (GAS f32x4*)(out + (size_t)(m + r * NGW) * DM) + lane;
#pragma unroll
            for (int j = 0; j < 4; ++j) { const u32x2 bb = b[r][j];
                f32x4 v = {__builtin_bit_cast(float, bb.x << 16), __builtin_bit_cast(float, bb.x & 0xFFFF0000u), __builtin_bit_cast(float, bb.y << 16), __builtin_bit_cast(float, bb.y & 0xFFFF0000u)};
                orow[64 * j] = v * rs[r] * gv[j]; } }
    }
}
namespace att {
constexpr int KSLOT = 12288, VSLOT = 8192;
constexpr int NSLOT = 4, TSLOT = KSLOT + VSLOT, L_K = 0, L_V = KSLOT, L_BIAS = NSLOT * TSLOT, L_END = L_BIAS + 1024;
constexpr float RESC_THR = 8.0f;
constexpr float NEGB = -1e30f;
__device__ __forceinline__ s16x4 vtr(const LAS unsigned char* p) { return __builtin_bit_cast(s16x4, __builtin_amdgcn_ds_read_tr16_b64_v4i16((LAS s16x4*)p)); }
__device__ __forceinline__ void swap32(float& x, float& y) { asm volatile("s_nop 1\n\tv_permlane32_swap_b32 %0, %1\n\ts_nop 0" : "+v"(x), "+v"(y)); }
__device__ __forceinline__ void swap32u(unsigned& x, unsigned& y) { asm volatile("s_nop 1\n\tv_permlane32_swap_b32 %0, %1\n\ts_nop 0" : "+v"(x), "+v"(y)); }
__device__ __forceinline__ void swap16(float& x, float& y) { asm volatile("s_nop 1\n\tv_permlane16_swap_b32 %0, %1\n\ts_nop 0" : "+v"(x), "+v"(y)); }
__device__ __forceinline__ float rows_max(float m) { float x = m + 0.f, y = m + 0.f; swap16(x, y); float t = __builtin_fmaxf(x, y) + 0.f; float x2 = t, y2 = t; swap32(x2, y2); return __builtin_fmaxf(x2, y2); }
__device__ __forceinline__ float rows_sum(float m) { float x = m + 0.f, y = m + 0.f; swap16(x, y); float t = x + y; float x2 = t, y2 = t; swap32(x2, y2); return x2 + y2; }
__device__ __forceinline__ float cnd(float neg, float s, unsigned long long mask) { return __builtin_amdgcn_inverse_ballot_w64(mask) ? s : neg; }

__device__ __forceinline__ void glds16s(const void* sbase, unsigned voff, unsigned lds_dst) { unsigned keep;
    asm volatile("s_mov_b32 %0, m0\n\ts_mov_b32 m0, %3\n\ts_nop 0\n\tglobal_load_lds_dwordx4 %1, %2\n\ts_mov_b32 m0, %0" : "=&s"(keep) : "v"(voff), "s"(sbase), "s"(lds_dst) : "memory"); }
template <int MODE>
__device__ __forceinline__ void attn_unit(Frame& F, int b, int h, int qb, const float* bias  , const unsigned* bmbase  , bool do_store = true, unsigned char* o8 = nullptr  ) {
    constexpr int DK = (MODE == 2) ? 96 : 64, NS = DK / 32;
    int tid_ = threadIdx.x; asm volatile("" : "+v"(tid_));
    const int tid = tid_, lane = tid & 63, l16 = lane & 15, rg = lane >> 4, wid = __builtin_amdgcn_readfirstlane(tid >> 6);
    const int Rrg = 8 * (rg & 1) + 4 * (rg >> 1);
    LAS unsigned char* const L = F.lds;
    unsigned char* const ws = opaque_global(F.ws);
    const int q0 = qb * 256;
    const size_t rowb = (size_t)b * SEQ;
    bf16_t* const QO = (bf16_t*)(ws + WS_QO);
    const int qcol = (MODE == 0) ? 64 * h : (MODE == 1) ? 384 + 64 * h : 704 + 64 * h;
    const bf16_t* Kb; const bf16_t* Vb; int kp, vp;
    if (MODE == 0) { Kb = (const bf16_t*)(ws + WS_KA) + 64 * h; Vb = (const bf16_t*)(ws + WS_VA) + 64 * h; kp = 384; vp = 384; }
    else if (MODE == 1) { Kb = (const bf16_t*)(ws + WS_KB) + 64 * h; Vb = (const bf16_t*)(ws + WS_VB) + 64 * h; kp = 320; vp = 320; }
    else { Kb = (const bf16_t*)(ws + WS_KN) + 64 * h; Vb = (const bf16_t*)(ws + WS_VC) + 64 * h; kp = 320; vp = 320; }
    const bf16_t* const KRb = (const bf16_t*)(ws + WS_KR);
    const int cw = 4 * qb + (wid >> 1);
    const int t_hi = 4 * qb + 3;
    const int t_lo = (MODE == 0) ? ((4 * qb - 8) > 0 ? (4 * qb - 8) : 0) : 0;
    bf16x8 qr[2][NS];
#pragma unroll
    for (int qb2 = 0; qb2 < 2; ++qb2) { const bf16_t* qrow = QO + (rowb + q0 + wid * 32 + 16 * qb2 + l16) * QO_PITCH;
#pragma unroll
      for (int s = 0; s < NS; ++s) { const bf16_t* p = (MODE == 2 && s == 2) ? qrow + 1024 + 32 * h + 8 * rg : qrow + qcol + 32 * s + 8 * rg; qr[qb2][s] = *(const bf16x8*)p; } }
    if (MODE == 0) { if (tid < 192) ((LAS float*)(L + L_BIAS))[tid] = bias[h * 192 + tid] * LOG2E; }
    const bf16_t* const ksb = Kb + rowb * kp; const bf16_t* const k2sb = KRb + rowb * 32; const bf16_t* const vsb = Vb + rowb * vp;
    const unsigned kvo = (unsigned)((lane * kp + wid * 8) * 2), k2vo = (unsigned)((lane * 32 + (wid & 3) * 8) * 2),
                   vvo = (unsigned)(((16 * (wid & 3) + (lane >> 2)) * vp + (wid >> 2) * 32 + (lane & 3) * 8) * 2);
    const bool w2 = (MODE == 2) && (wid < 4);
    const unsigned lds0 = (unsigned)(size_t)L;
#define DMA_T(t, s) do { glds16s(ksb + (size_t)(t) * 64 * kp, kvo, (unsigned)__builtin_amdgcn_readfirstlane(lds0 + L_K + (s) * TSLOT + wid * 1024)); \
        glds16s(vsb + (size_t)(t) * 64 * vp, vvo, (unsigned)__builtin_amdgcn_readfirstlane(lds0 + L_V + (s) * TSLOT + wid * 1024)); \
        if (w2) glds16s(k2sb + (size_t)(t) * 64 * 32, k2vo, (unsigned)__builtin_amdgcn_readfirstlane(lds0 + L_K + (s) * TSLOT + (8 + wid) * 1024)); } while (0)
#define WAIT_BAR(more) do { if (more) { if (w2) asm volatile("s_waitcnt vmcnt(3) lgkmcnt(0)" ::: "memory"); else asm volatile("s_waitcnt vmcnt(2) lgkmcnt(0)" ::: "memory"); } \
        else asm volatile("s_waitcnt vmcnt(0) lgkmcnt(0)" ::: "memory"); __builtin_amdgcn_s_barrier(); asm volatile("" ::: "memory"); } while (0)
#define VIS(t) ((MODE == 0) ? ((t) <= cw && (t) + 8 >= cw) : ((t) <= cw))
    const LAS unsigned char* const kfb = L + L_K + rg * 1024 + (8 * ((l16 >> 2) & 1) + 4 * (l16 >> 3) + (l16 & 3)) * 16;
    const LAS unsigned char* const vfb = L + L_V + (Rrg + (l16 >> 2)) * 64 + (l16 & 3) * 8;
#define KLOAD(s) do { const LAS unsigned char* kf_ = kfb + (s) * TSLOT; \
        _Pragma("unroll") for (int kb = 0; kb < 4; ++kb) _Pragma("unroll") for (int ss = 0; ss < NS; ++ss) kfr[kb][ss] = *(const LAS bf16x8*)(kf_ + ss * 4096 + kb * 256); } while (0)
#define QKS(SN, ss) do { _Pragma("unroll") for (int kb = 0; kb < 4; ++kb) _Pragma("unroll") for (int qb2 = 0; qb2 < 2; ++qb2) \
        SN[kb][qb2] = __builtin_amdgcn_mfma_f32_16x16x32_bf16(kfr[kb][ss], qr[qb2][ss], (ss) == 0 ? negm[qb2] : SN[kb][qb2], 0, 0, 0); } while (0)
#define VREAD(V, ks) do { _Pragma("unroll") for (int dvb = 0; dvb < 4; ++dvb) { const LAS unsigned char* p_ = vf_ + (dvb >> 1) * 4096 + (dvb & 1) * 32 + (ks) * 2048; \
        const s16x4 lo_ = vtr(p_), hi_ = vtr(p_ + 1024); V[dvb] = (bf16x8){lo_[0], lo_[1], lo_[2], lo_[3], hi_[0], hi_[1], hi_[2], hi_[3]}; } } while (0)
    f32x4 O[4][2];
    f32x4 negm[2];
    float mref[2]; bool have[2];
    f32x4 lacc[2];
    bool robust_all = false;
    const s16x4 ones4 = {(short)0x3F80, (short)0x3F80, (short)0x3F80, (short)0x3F80};
    const int qpos0 = q0 + wid * 32 + l16;
    const unsigned* bmw = bmbase + ((size_t)(b * 256 + 8 * qb + wid)) * 8192;
#define FENCE __builtin_amdgcn_sched_barrier(0)
#define MASKKB(X, kb0, t) do { \
        if (MODE == 0) { const LAS float* bl = (const LAS float*)(L + L_BIAS); \
            if (cw - (t) >= 3) { const float bf = bl[191]; _Pragma("unroll") for (int kb = (kb0); kb < (kb0) + 2; ++kb) _Pragma("unroll") for (int qb2 = 0; qb2 < 2; ++qb2) _Pragma("unroll") for (int i = 0; i < 4; ++i) X[kb][qb2][i] += bf; } \
            else { _Pragma("unroll") for (int kb = (kb0); kb < (kb0) + 2; ++kb) _Pragma("unroll") for (int qb2 = 0; qb2 < 2; ++qb2) _Pragma("unroll") for (int i = 0; i < 4; ++i) { \
                    const int ra = qpos0 + 16 * qb2 - 64 * (t) - 16 * kb - Rrg - i; const int ia = (ra < -63 ? -63 : (ra > 128 ? 128 : ra)) + 63; X[kb][qb2][i] += bl[ia]; } } } \
        if (MODE == 1) { _Pragma("unroll") for (int kb = (kb0); kb < (kb0) + 2; ++kb) _Pragma("unroll") for (int qb2 = 0; qb2 < 2; ++qb2) { const u32x8 w = mw_[kb * 2 + qb2]; \
                _Pragma("unroll") for (int i = 0; i < 4; ++i) { const unsigned long long mk = ((unsigned long long)w[2 * i + 1] << 32) | (unsigned long long)w[2 * i]; X[kb][qb2][i] = cnd(NEGB, X[kb][qb2][i], mk); } } } } while (0)
#define EXPG(X, qb2, ks) do { _Pragma("unroll") for (int i = 0; i < 4; ++i) { X[2 * (ks)][qb2][i] = __builtin_amdgcn_exp2f(X[2 * (ks)][qb2][i]); X[2 * (ks) + 1][qb2][i] = __builtin_amdgcn_exp2f(X[2 * (ks) + 1][qb2][i]); } \
        pw[qb2][ks][0] = pg8::cvt_pk_bf16(X[2 * (ks)][qb2][0], X[2 * (ks)][qb2][1]) & vism_; pw[qb2][ks][1] = pg8::cvt_pk_bf16(X[2 * (ks)][qb2][2], X[2 * (ks)][qb2][3]) & vism_; \
        pw[qb2][ks][2] = pg8::cvt_pk_bf16(X[2 * (ks) + 1][qb2][0], X[2 * (ks) + 1][qb2][1]) & vism_; pw[qb2][ks][3] = pg8::cvt_pk_bf16(X[2 * (ks) + 1][qb2][2], X[2 * (ks) + 1][qb2][3]) & vism_; \
        lacc[qb2] = __builtin_amdgcn_mfma_f32_4x4x4bf16_1k(ones4, __builtin_bit_cast(s16x4, (u32x2){pw[qb2][ks][0], pw[qb2][ks][1]}), lacc[qb2], 0, 0, 0); \
        lacc[qb2] = __builtin_amdgcn_mfma_f32_4x4x4bf16_1k(ones4, __builtin_bit_cast(s16x4, (u32x2){pw[qb2][ks][2], pw[qb2][ks][3]}), lacc[qb2], 0, 0, 0); } while (0)
#define PVG(V, qb2, ks) do { const bf16x8 pf = __builtin_bit_cast(bf16x8, pw[qb2][ks]); \
        _Pragma("unroll") for (int dvb = 0; dvb < 4; ++dvb) O[dvb][qb2] = __builtin_amdgcn_mfma_f32_16x16x32_bf16(V[dvb], pf, O[dvb][qb2], 0, 0, 0); } while (0)
#define STEPF(SC, SN, t, s, FAST) do { \
        const cu8* mp_ = (const cu8*)(bmw + 64 * (t)); (void)mp_; \
        const LAS unsigned char* vf_ = vfb + (s) * TSLOT; \
        u32x8 mw_[8]; if (MODE == 1) { _Pragma("unroll") for (int v = 0; v < 8; ++v) mw_[v] = mp_[v]; }     \
        KLOAD(((s) + 1) & 3); \
        FENCE; \
        QKS(SN, 0); MASKKB(SC, 0, t); FENCE; \
        QKS(SN, 1); MASKKB(SC, 2, t); FENCE; \
        if (NS == 3) { QKS(SN, 2); } \
        float dlt[2] = {0.f, 0.f}; \
        if (!(FAST)) {                                          \
            _Pragma("unroll") for (int qb2 = 0; qb2 < 2; ++qb2) { float rm = SC[0][qb2][0]; \
                _Pragma("unroll") for (int kb = 0; kb < 4; ++kb) _Pragma("unroll") for (int i = 0; i < 4; ++i) rm = __builtin_fmaxf(rm, SC[kb][qb2][i]); \
                rm = rows_max(rm); rm = visc_ ? rm : NEGB;      \
                dlt[qb2] = have[qb2] ? (rm > RESC_THR ? rm : 0.f) : (rm > -1e20f ? rm : 0.f); \
                have[qb2] = have[qb2] || (rm > -1e20f); } } \
        VREAD(va, 0); \
        if (!(FAST)) { if (__any(dlt[0] != 0.f || dlt[1] != 0.f)) { _Pragma("unroll") for (int qb2 = 0; qb2 < 2; ++qb2) { mref[qb2] += dlt[qb2]; const float f = __builtin_amdgcn_exp2f(-dlt[qb2]); lacc[qb2] *= f; \
            const float nm = -mref[qb2]; negm[qb2] = (f32x4){nm, nm, nm, nm}; \
            _Pragma("unroll") for (int kb = 0; kb < 4; ++kb) { O[kb][qb2] *= f; SC[kb][qb2] -= dlt[qb2]; SN[kb][qb2] -= dlt[qb2]; } } } } \
        FENCE; \
        EXPG(SC, 0, 0); VREAD(vb, 1); FENCE; \
        PVG(va, 0, 0); EXPG(SC, 1, 0); FENCE; \
        PVG(va, 1, 0); EXPG(SC, 0, 1); FENCE; \
        PVG(vb, 0, 1); EXPG(SC, 1, 1); FENCE; \
        PVG(vb, 1, 1); if (dma_) DMA_T((t) + 3, ((s) + 3) & 3); \
    } while (0)
#define STEP(SC, SN, t, s, AV, FAST) do { \
        const bool dma_ = (t) + 3 <= t_hi; \
        const bool visc_ = (AV) ? true : VIS(t); const unsigned vism_ = visc_ ? 0xFFFFFFFFu : 0u;     \
        STEPF(SC, SN, t, s, FAST); \
        WAIT_BAR((t) + 3 <= t_hi); } while (0)
    f32x4 sa[4][2], sb[4][2];
    bf16x8 kfr[4][NS], va[4], vb[4]; u32x4 pw[2][2];
    float lsum[2];
    typedef unsigned u32x8 __attribute__((ext_vector_type(8))); typedef __attribute__((address_space(4))) const u32x8 cu8;
  for (;;) {
#pragma unroll
    for (int qb2 = 0; qb2 < 2; ++qb2) { negm[qb2] = (f32x4){0.f, 0.f, 0.f, 0.f}; lacc[qb2] = (f32x4){0.f, 0.f, 0.f, 0.f}; mref[qb2] = 0.f; have[qb2] = false;
#pragma unroll
        for (int kb = 0; kb < 4; ++kb) { O[kb][qb2] = (f32x4){0.f, 0.f, 0.f, 0.f}; sa[kb][qb2] = (f32x4){0.f, 0.f, 0.f, 0.f}; sb[kb][qb2] = (f32x4){0.f, 0.f, 0.f, 0.f}; } }
    DMA_T(t_lo, 0); DMA_T(t_lo + 1, 1); DMA_T(t_lo + 2, 2);
#pragma unroll
    for (int qb2 = 0; qb2 < 2; ++qb2)
#pragma unroll
        for (int s = 0; s < NS; ++s) asm volatile("" :: "v"(qr[qb2][s]));
    asm volatile("s_waitcnt vmcnt(0)" ::: "memory");
    WAIT_BAR(true);
    { KLOAD(0);
#pragma unroll
      for (int s = 0; s < NS; ++s) QKS(sa, s); }
    int t = t_lo;
#define PAIR(AV, FAST) do { const int s = (t - t_lo) & 3; STEP(sa, sb, t, s, AV, FAST); STEP(sb, sa, t + 1, (s + 1) & 3, AV, FAST); } while (0)
    if (MODE != 0) {
        for (; t < 4 * qb && (robust_all || !__all(have[0] && have[1])); t += 2) PAIR(true, false);
        for (; t < 4 * qb; t += 2) PAIR(true, true);
    }
    for (; t <= t_hi && (robust_all || !__all(have[0] && have[1])); t += 2) PAIR(false, false);
    for (; t <= t_hi; t += 2) PAIR(false, true);
#undef PAIR
    lsum[0] = rows_sum(lacc[0][0]); lsum[1] = rows_sum(lacc[1][0]);
    if (robust_all) break;
    if (__any(!(lsum[0] < 1.0e30f) || !(lsum[1] < 1.0e30f)) && lane == 0) F.MISC[4] = 1u;
    __syncthreads();
    const unsigned again = F.MISC[4];
    __syncthreads();
    if (again == 0u) break;
    if (tid == 0) F.MISC[4] = 0u;
    robust_all = true;
  }
#undef STEP
#undef STEPF
#undef FENCE
#undef QKS
#undef MASKKB
#undef VREAD
#undef EXPG
#undef PVG
#undef KLOAD
#undef VIS
#undef DMA_T
#undef WAIT_BAR
#pragma unroll
    for (int qb2 = 0; qb2 < 2; ++qb2) {
        const float linv = __builtin_amdgcn_rcpf(lsum[qb2]);
        bf16_t* orow = QO + (rowb + q0 + wid * 32 + 16 * qb2 + l16) * QO_PITCH + qcol + 4 * rg;
#pragma unroll
        for (int dvb = 0; dvb < 4; ++dvb) {
            u32x2 w; w.x = pg8::cvt_pk_bf16(O[dvb][qb2][0] * linv, O[dvb][qb2][1] * linv); w.y = pg8::cvt_pk_bf16(O[dvb][qb2][2] * linv, O[dvb][qb2][3] * linv);
            if (o8) { float q[4];
#pragma unroll
                for (int i = 0; i < 4; ++i) q[i] = __builtin_fminf(__builtin_fmaxf(O[dvb][qb2][i] * (linv * O_F8_SCALE), -448.0f), 448.0f);
                int w8 = 0; w8 = __builtin_amdgcn_cvt_pk_fp8_f32(q[0], q[1], w8, false); w8 = __builtin_amdgcn_cvt_pk_fp8_f32(q[2], q[3], w8, true);
                if (do_store) *(unsigned*)(o8 + (rowb + q0 + wid * 32 + 16 * qb2 + l16) * (size_t)DM + qcol + 4 * rg + 16 * dvb) = (unsigned)w8; }
            else if (do_store) *(u32x2*)(orow + 16 * dvb) = w;
        }
    }
}
}
namespace sel {
constexpr int CAP = 256;
constexpr int L_HIST = 0, L_WORDS = 65536, L_WT = 98304, L_THR = 99328, L_CNT = 99840, L_PFX = 99968, L_SUB = 100224, L_END = 108416;
__device__ __forceinline__ unsigned wave_suffix_incl(unsigned v) {
    unsigned t = v;
    t += (unsigned)__builtin_amdgcn_update_dpp(0, (int)t, 0x111, 0xF, 0xF, false);
    t += (unsigned)__builtin_amdgcn_update_dpp(0, (int)t, 0x112, 0xF, 0xF, false);
    t += (unsigned)__builtin_amdgcn_update_dpp(0, (int)t, 0x114, 0xF, 0xF, false);
    t += (unsigned)__builtin_amdgcn_update_dpp(0, (int)t, 0x118, 0xF, 0xF, false);
    t += (unsigned)__builtin_amdgcn_update_dpp(0, (int)t, 0x142, 0xA, 0xF, false);
    t += (unsigned)__builtin_amdgcn_update_dpp(0, (int)t, 0x143, 0xC, 0xF, false);
    const unsigned tot = (unsigned)__builtin_amdgcn_readlane((int)t, 63);
    return tot - t + v;
}
__device__ __forceinline__ unsigned mono(float s) { const unsigned u = __builtin_bit_cast(unsigned, s); return u ^ ((unsigned)((int)u >> 31) | 0x80000000u); }
typedef short s16x2 __attribute__((ext_vector_type(2)));
__device__ __forceinline__ void score_tile(const bf16x8 (&af)[2], const bf16x8 (&bf)[2], const bf16x8 (&wa)[2], float& sA, float& sB) {
    f32x16 c = {};
    c = __builtin_amdgcn_mfma_f32_32x32x16_bf16(af[0], bf[0], c, 0, 0, 0);
    c = __builtin_amdgcn_mfma_f32_32x32x16_bf16(af[1], bf[1], c, 0, 0, 0);
    f32x16 o = {};
#pragma unroll
    for (int s = 0; s < 2; ++s) {
        u32x4 pk;
#pragma unroll
        for (int m = 0; m < 4; ++m) { const unsigned u = pg8::cvt_pk_bf16(c[8 * s + 2 * m], c[8 * s + 2 * m + 1]);
            const s16x2 v = __builtin_elementwise_max(__builtin_bit_cast(s16x2, u), (s16x2){0, 0});
            pk[m] = __builtin_bit_cast(unsigned, v); }
        o = __builtin_amdgcn_mfma_f32_32x32x16_bf16(wa[s], __builtin_bit_cast(bf16x8, pk), o, 0, 0, 0);
    }
    sA = o[0]; sB = o[1];
}
__device__ __forceinline__ void make_wa(const LAS float* WT, int qb4, int r32, int hi, bf16x8 (&wa)[2]) {
    const int gl = (r32 == 0) ? 0 : (r32 == 1) ? 1 : (r32 == 4) ? 2 : (r32 == 5) ? 3 : -1;
    const f32x4 w4 = *(const LAS f32x4*)(WT + (qb4 + (gl < 0 ? 0 : gl)) * 8 + 4 * hi);
    const unsigned p0 = gl < 0 ? 0u : pg8::cvt_pk_bf16(w4[0], w4[1]), p1 = gl < 0 ? 0u : pg8::cvt_pk_bf16(w4[2], w4[3]);
    u32x4 x0 = {0u, 0u, 0u, 0u}, x1 = {0u, 0u, 0u, 0u};
    if (gl == 0) { x0[0] = p0; x0[1] = p1; } else if (gl == 1) { x0[2] = p0; x0[3] = p1; } else if (gl == 2) { x1[0] = p0; x1[1] = p1; } else if (gl == 3) { x1[2] = p0; x1[3] = p1; }
    wa[0] = __builtin_bit_cast(bf16x8, x0); wa[1] = __builtin_bit_cast(bf16x8, x1);
}
__device__ __forceinline__ void sel_unit(Frame& F, int b, int qg, unsigned* bmbase, const bf16_t* wiw  ) {
    int tid_ = threadIdx.x; asm volatile("" : "+v"(tid_));
    const int tid = tid_, lane = tid & 63, r32 = lane & 31, hi = lane >> 5, wid = __builtin_amdgcn_readfirstlane(tid >> 6);
    LAS unsigned char* const L = F.lds; unsigned char* const ws = opaque_global(F.ws);
    const int n = 64 * ((qg >> 1) + 1), ntile = n / 32;
    const size_t rowb = (size_t)b * SEQ; const size_t q0 = rowb + 32 * qg;
    const bf16_t* const IQ = (const bf16_t*)(ws + WS_IQ); const bf16_t* const IK = (const bf16_t*)(ws + WS_IK);
    LAS float* const WT = (LAS float*)(L + L_WT);
    LAS unsigned* const THR = (LAS unsigned*)(L + L_THR);
    LAS unsigned* const CNT = (LAS unsigned*)(L + L_CNT);
    LAS unsigned* const PFX = (LAS unsigned*)(L + L_PFX);
    LAS unsigned* const WORDS = (LAS unsigned*)(L + L_WORDS);
    {
        const bf16_t* const XBp = (const bf16_t*)(ws + WS_XB); const float* const STX = (const float*)(ws + WS_STATX);
        LAS float* const PART = (LAS float*)(L + L_HIST);
        float rsq_ = 0.f; if (tid < 256) rsq_ = pg8::row_rs(STX, (int)(q0 + (tid >> 3)));
        bf16x8 wa_[8], xb_[8];
#pragma unroll
        for (int s = 0; s < 8; ++s) { const int k0 = 16 * (8 * wid + s) + 8 * hi; wa_[s] = *(const bf16x8*)(wiw + (size_t)r32 * DM + k0); xb_[s] = *(const bf16x8*)(XBp + (q0 + r32) * DM + k0); }
        f32x16 c = {};
#pragma unroll
        for (int s = 0; s < 8; ++s) c = __builtin_amdgcn_mfma_f32_32x32x16_bf16(wa_[s], xb_[s], c, 0, 0, 0);
        *(LAS f32x4*)(PART + (wid * 32 + r32) * 8 + 4 * hi) = (f32x4){c[0], c[1], c[2], c[3]};
        __syncthreads();
        if (tid < 256) { const int q = tid >> 3, h = tid & 7; float sm = 0.f;
#pragma unroll
            for (int w = 0; w < 8; ++w) sm += PART[(w * 32 + q) * 8 + h];
            WT[tid] = sm * rsq_; }
    }
    if (tid < 32) { THR[4 * tid] = 1u; THR[4 * tid + 1] = 0u; THR[4 * tid + 2] = 0u; CNT[tid] = 0u; }
    __syncthreads();
    const bf16_t* const ikb = IK + (rowb + r32) * 32 + 8 * hi;
    if (n > 256) {
        for (int sub = 0; sub < 4; ++sub) {
            bf16x8 af[2][2], w[2][2];
#pragma unroll
            for (int mt = 0; mt < 2; ++mt) {
#pragma unroll
                for (int ks = 0; ks < 2; ++ks) af[mt][ks] = *(const bf16x8*)(IQ + (q0 + 8 * sub + 4 * mt) * 256 + r32 * 32 + 16 * ks + 8 * hi);
                make_wa(WT, 8 * sub + 4 * mt, r32, hi, w[mt]);
            }
            if (tid < 8) { PFX[8 * tid] = 0u; PFX[8 * tid + 1] = 0u; PFX[8 * tid + 2] = 0u; PFX[8 * tid + 3] = 0u; }
            for (int level = 0; level < 3; ++level) {
                for (int i = tid; i < 16384; i += 512) ((LAS unsigned*)(L + L_HIST))[i] = 0u;
                __syncthreads();
                const int sh = (level == 0) ? 20 : (level == 1 ? 8 : 0);
                const unsigned bmask = (level == 2) ? 0xFFu : 0xFFFu;
                unsigned pfxr[2][2], plenr[2][2];
#pragma unroll
                for (int mt = 0; mt < 2; ++mt)
#pragma unroll
                    for (int j = 0; j < 2; ++j) { const int qs = 4 * mt + 2 * hi + j; pfxr[mt][j] = PFX[8 * qs]; plenr[mt][j] = PFX[8 * qs + 1]; }
#define SEL_LOADBF(dst, k) do { const int k_ = (k) < ntile ? (k) : (ntile - 1); dst[0] = *(const bf16x8*)(ikb + (size_t)k_ * 1024); dst[1] = *(const bf16x8*)(ikb + (size_t)k_ * 1024 + 16); } while (0)
#define SEL_P1_TILE(bf) do { float sc_[2][2];                \
                        _Pragma("unroll") for (int mt = 0; mt < 2; ++mt) score_tile(af[mt], bf, w[mt], sc_[mt][0], sc_[mt][1]); \
                        _Pragma("unroll") for (int mt = 0; mt < 2; ++mt) { \
                        _Pragma("unroll") for (int j = 0; j < 2; ++j) { const unsigned key = mono(sc_[mt][j]); const int qs = 4 * mt + 2 * hi + j; const unsigned pfx = pfxr[mt][j], plen = plenr[mt][j]; \
                            const bool match = (plen == 0u) || ((key >> (32u - plen)) == pfx); \
                            if (match) { const unsigned bin = (key >> sh) & bmask; \
                                __hip_atomic_fetch_add((LAS unsigned*)(L + L_HIST + qs * 8192 + (bin >> 1) * 4), 1u << (16 * (bin & 1)), __ATOMIC_RELAXED, __HIP_MEMORY_SCOPE_WORKGROUP); } } } } while (0)
#define SEL_P1_TILE0(bf) do { float sc_[2][2]; \
                        _Pragma("unroll") for (int mt = 0; mt < 2; ++mt) score_tile(af[mt], bf, w[mt], sc_[mt][0], sc_[mt][1]); \
                        _Pragma("unroll") for (int mt = 0; mt < 2; ++mt) { \
                        _Pragma("unroll") for (int j = 0; j < 2; ++j) { const unsigned key = __builtin_bit_cast(unsigned, sc_[mt][j]); \
                                unsigned ho_; asm("v_and_or_b32 %0, %1, %2, %3" : "=v"(ho_) : "v"(key >> 19), "s"(0x1FFCu), "v"(hbo)); \
                                __hip_atomic_fetch_add((LAS unsigned*)(ho_ + (unsigned)((4 * mt + j) * 8192)), 1u << ((key >> 16) & 16u), __ATOMIC_RELAXED, __HIP_MEMORY_SCOPE_WORKGROUP); } } } while (0)
                {
                    bf16x8 bA[2], bB[2]; SEL_LOADBF(bA, wid); SEL_LOADBF(bB, wid + 8);
                    if (level == 0) {
                        const unsigned hbo = (unsigned)(size_t)(L + L_HIST) + (unsigned)hi * 16384u;
                        for (int kt = wid; kt < ntile; kt += 16) {
                            SEL_P1_TILE0(bA); SEL_LOADBF(bA, kt + 16);
                            if (kt + 8 < ntile) { SEL_P1_TILE0(bB); } SEL_LOADBF(bB, kt + 24);
                        }
                    } else
                    for (int kt = wid; kt < ntile; kt += 16) {
                        SEL_P1_TILE(bA); SEL_LOADBF(bA, kt + 16);
                        if (kt + 8 < ntile) { SEL_P1_TILE(bB); } SEL_LOADBF(bB, kt + 24);
                    }
                }
                __syncthreads();
                {
                    const int qs = wid; const LAS unsigned short* hq = (const LAS unsigned short*)(L + L_HIST + qs * 8192);
                    const unsigned above = PFX[8 * qs + 2]; const unsigned need = 256u - above;
                    unsigned tl = 0;
                    const int seg = (level == 0) ? (lane >= 32 ? lane - 32 : 63 - lane) : lane;
                    for (int i = 0; i < 32; ++i) { const unsigned v = *(const LAS unsigned*)(hq + 64 * seg + 2 * i); tl += (v & 0xFFFFu) + (v >> 16); }
                    const unsigned suf = wave_suffix_incl(tl);
                    const unsigned sabove = suf - tl;
                    const bool cross = (sabove < need && need <= sabove + tl);
                    const unsigned long long cm = __ballot(cross);
                    const int cl = cm ? (int)__builtin_ctzll(cm) : 63;
                    const unsigned sab0 = __builtin_amdgcn_readlane(sabove, cl);
                    const unsigned cb = hq[(level == 0) ? (cl >= 32 ? 64 * (cl - 32) + lane : 4095 - 64 * cl - lane) : (64 * cl + lane)];
                    const unsigned suf2 = wave_suffix_incl(cb);
                    const unsigned ab2 = sab0 + suf2 - cb;
                    if (ab2 < need && need <= ab2 + cb) { const unsigned bits = (level == 2) ? 8u : 12u;
                        PFX[8 * qs + 4] = (PFX[8 * qs] << bits) | (unsigned)(64 * cl + lane); PFX[8 * qs + 5] = PFX[8 * qs + 1] + bits; PFX[8 * qs + 6] = above + ab2; PFX[8 * qs + 7] = cb; }
                }
                __syncthreads();
                if (tid < 8) { PFX[8 * tid] = PFX[8 * tid + 4]; PFX[8 * tid + 1] = PFX[8 * tid + 5]; PFX[8 * tid + 2] = PFX[8 * tid + 6]; PFX[8 * tid + 3] = PFX[8 * tid + 7]; }
                __syncthreads();
                unsigned mx = 0;
#pragma unroll
                for (int q = 0; q < 8; ++q) { const unsigned cq = PFX[8 * q + 3]; mx = cq > mx ? cq : mx; }
                if (mx <= (unsigned)CAP) break;
            }
            if (tid < 8) { const unsigned pfx = PFX[8 * tid], plen = PFX[8 * tid + 1]; const unsigned lo = (plen >= 32u) ? pfx : (pfx << (32u - plen));
                const unsigned hi_k = (plen >= 32u) ? pfx : (lo | ((1u << (32u - plen)) - 1u));
                THR[4 * (8 * sub + tid)] = lo; THR[4 * (8 * sub + tid) + 1] = hi_k; THR[4 * (8 * sub + tid) + 2] = 256u - PFX[8 * tid + 2]; }
            __syncthreads();
        }
    }
    LAS unsigned* const CAND = (LAS unsigned*)(L + L_HIST);
    for (int hf = 0; hf < 2; ++hf) {
        bf16x8 af[4][2], w[4][2]; unsigned tlo[4][2], thi[4][2], xr[4][2];
#pragma unroll
        for (int mt = 0; mt < 4; ++mt) {
#pragma unroll
            for (int ks = 0; ks < 2; ++ks) af[mt][ks] = *(const bf16x8*)(IQ + (q0 + 16 * hf + 4 * mt) * 256 + r32 * 32 + 16 * ks + 8 * hi);
            make_wa(WT, 16 * hf + 4 * mt, r32, hi, w[mt]);
#pragma unroll
            for (int j = 0; j < 2; ++j) { const int q = 16 * hf + 4 * mt + 2 * hi + j; const unsigned lo_ = THR[4 * q], hi_ = THR[4 * q + 1];
                xr[mt][j] = (hi_ & 0x80000000u) ? 0u : 0x7FFFFFFFu; tlo[mt][j] = lo_ ^ 0x80000000u; thi[mt][j] = hi_ ^ 0x80000000u; }
        }
#define SEL_P2_TILE(bf, kt_) do { unsigned bits = 0u; float sc_[4][2]; \
            _Pragma("unroll") for (int mt = 0; mt < 4; ++mt) score_tile(af[mt], bf, w[mt], sc_[mt][0], sc_[mt][1]); \
            _Pragma("unroll") for (int mt = 0; mt < 4; ++mt) { \
                _Pragma("unroll") for (int j = 0; j < 2; ++j) { const int w_ = (int)(__builtin_bit_cast(unsigned, sc_[mt][j]) ^ xr[mt][j]); \
                    unsigned long long ms_ = __builtin_amdgcn_ballot_w64(w_ > (int)thi[mt][j]); asm volatile("" : "+s"(ms_)); const bool selq = __builtin_amdgcn_inverse_ballot_w64(ms_); \
                    bits |= selq ? (1u << (4 * mt + j)) : 0u; \
                    if (!selq && w_ >= (int)tlo[mt][j]) { const int q = 16 * hf + 4 * mt + 2 * hi + j; const unsigned key = mono(sc_[mt][j]); \
                        const unsigned slot = __hip_atomic_fetch_add(CNT + q, 1u, __ATOMIC_RELAXED, __HIP_MEMORY_SCOPE_WORKGROUP); \
                        if (slot < (unsigned)CAP) { CAND[(q * CAP + slot) * 2] = key; CAND[(q * CAP + slot) * 2 + 1] = (unsigned)(32 * (kt_) + r32); } } } } \
            bits <<= (2 * hi); unsigned bx = bits, by = bits; att::swap32u(bx, by); const unsigned tot = bx | by; \
            if (hi == 0) ((LAS unsigned short*)WORDS)[(32 * (kt_) + r32) * 2 + hf] = (unsigned short)tot; } while (0)
        {
            bf16x8 bA[2], bB[2]; SEL_LOADBF(bA, wid); SEL_LOADBF(bB, wid + 8);
            for (int kt = wid; kt < ntile; kt += 16) {
                SEL_P2_TILE(bA, kt); SEL_LOADBF(bA, kt + 16);
                if (kt + 8 < ntile) { SEL_P2_TILE(bB, kt + 8); } SEL_LOADBF(bB, kt + 24);
            }
        }
    }
    __syncthreads();
    {
        LAS unsigned* const SUB = (LAS unsigned*)(L + L_SUB) + wid * 256;
        for (int qi = 0; qi < 4; ++qi) {
            const int q = wid + 8 * qi;
            unsigned cnt = __builtin_amdgcn_readfirstlane(CNT[q]); cnt = cnt > (unsigned)CAP ? 0u : cnt;
            const unsigned need = __builtin_amdgcn_readfirstlane(THR[4 * q + 2]);
            if (cnt == 0u || need == 0u) continue;
            const unsigned span = __builtin_amdgcn_readfirstlane(THR[4 * q + 1] - THR[4 * q]);
            const int s2 = (span >= 0xFFFFFu) ? 12 : 0;
            unsigned key[4], idx[4], sb[4]; bool val[4];
#pragma unroll
            for (int i = 0; i < 4; ++i) { const unsigned c = lane + 64 * i; val[i] = c < cnt; const u32x2 e = *(const LAS u32x2*)(CAND + (q * CAP + (val[i] ? c : 0u)) * 2); key[i] = e.x; idx[i] = e.y; sb[i] = (e.x >> s2) & 0xFFu; SUB[lane + 64 * i] = 0u; }
#pragma unroll
            for (int i = 0; i < 4; ++i) if (val[i]) __hip_atomic_fetch_add(SUB + sb[i], 1u, __ATOMIC_RELAXED, __HIP_MEMORY_SCOPE_WORKGROUP);
            const u32x4 hb = *(const LAS u32x4*)(SUB + 4 * lane);
            const unsigned tl = (hb[0] + hb[1]) + (hb[2] + hb[3]);
            const unsigned suf = wave_suffix_incl(tl);
            const unsigned sabove = suf - tl;
            const bool cross = (sabove < need && need <= sabove + tl);
            unsigned b2 = 0u, ab2 = 0u;
            if (cross) { unsigned acc = sabove; b2 = 4u * lane + 3u; ab2 = acc;
#pragma unroll
                for (int e = 3; e >= 0; --e) { if (acc + hb[e] >= need) { b2 = 4u * lane + e; ab2 = acc; break; } acc += hb[e]; } }
            const unsigned long long cm = __ballot(cross);
            const int cl = cm ? (int)__builtin_ctzll(cm) : 0;
            b2 = __builtin_amdgcn_readlane(b2, cl); ab2 = __builtin_amdgcn_readlane(ab2, cl);
            const unsigned need2 = need - ab2;
            bool same[4]; unsigned rank[4];
#pragma unroll
            for (int i = 0; i < 4; ++i) { same[i] = val[i] && sb[i] == b2; rank[i] = 0u; }
#pragma unroll
            for (int i2 = 0; i2 < 4; ++i2) {
                unsigned long long m = __ballot(same[i2]);
                while (m) { const int sl = (int)__builtin_ctzll(m); m &= m - 1ull;
                    const unsigned kj = __builtin_amdgcn_readlane(key[i2], sl), ij = __builtin_amdgcn_readlane(idx[i2], sl);
#pragma unroll
                    for (int i = 0; i < 4; ++i) rank[i] += (same[i] && (kj > key[i] || (kj == key[i] && ij < idx[i]))) ? 1u : 0u; }
            }
#pragma unroll
            for (int i = 0; i < 4; ++i) if (val[i] && (sb[i] > b2 || (same[i] && rank[i] < need2))) __hip_atomic_fetch_or(WORDS + idx[i], 1u << q, __ATOMIC_RELAXED, __HIP_MEMORY_SCOPE_WORKGROUP);
        }
    }
    __syncthreads();
    unsigned* const bm = bmbase + ((size_t)(b * 256 + qg)) * 8192;
    for (int o = tid; o < n; o += 512) { const int T = o >> 6, w = o & 63, mi = w >> 1, hh = w & 1, kb = mi >> 3, qb2 = (mi >> 2) & 1, i = mi & 3;
        const int k0 = 64 * T + 16 * kb + 4 * hh + i; const unsigned wa = WORDS[k0], wb = WORDS[k0 + 8];
        bm[o] = ((wa >> (16 * qb2)) & 0xFFFFu) | (((wb >> (16 * qb2)) & 0xFFFFu) << 16); }
    __syncthreads();
}
}
constexpr int PH_PRO = 0, PH_L0 = 1, PH_PER_LAYER = 8, PH_FNORM = PH_L0 + DEPTH * PH_PER_LAYER, NPH = PH_FNORM + 1;
enum { L_GU1 = 0, L_D1, L_WIN, L_MIXA, L_MIXB, L_WOUT, L_GU2, L_D2 };
#ifndef PROBE_DUP
#define PROBE_DUP -1
#endif
#define NREP(kind) ((PROBE_DUP == (kind) || ((kind) == L_MIXB && (PROBE_DUP == 41 || PROBE_DUP == 42))) ? 2 : 1)
#ifndef MK_ONE_LAUNCH
#define MK_ONE_LAUNCH 1
#endif
__device__ __forceinline__ int queue_next(Frame& F, int qid) {
    if (threadIdx.x == 0) F.MISC[0] = __hip_atomic_fetch_add(F.ctl + CW_Q + 64 * qid, 1u, RLX_AGENT);
    __syncthreads(); const int v = __builtin_amdgcn_readfirstlane((int)F.MISC[0]); __syncthreads(); return v;
}
__device__ __forceinline__ int opaque_bx() { int b = blockIdx.x; asm volatile("" : "+s"(b)); return b; }
__device__ __forceinline__ void zero_o(Frame& F, int b, int qb, int col) {
    unsigned char* const ws_ = opaque_global(F.ws); int tid = threadIdx.x; asm volatile("" : "+v"(tid)); bf16_t* QO = (bf16_t*)(ws_ + WS_QO);
    for (int i = tid; i < 256 * 8; i += 512) { const int r = i >> 3, c = (i & 7) * 8; *(u32x4*)(QO + ((size_t)b * SEQ + qb * 256 + r) * QO_PITCH + col + c) = (u32x4){0u, 0u, 0u, 0u}; }
}
#ifndef PAIR_DEAL
#define PAIR_DEAL 0
#endif
#if PAIR_DEAL
#define SINIT init_pair
#else
#define SINIT init
#endif
struct Args { In in; float* out; unsigned char* ws; int ph_lo, ph_hi; };
#define IN(k) (lo <= (k) && (k) < hi)
#define SEAM(k) do { if (IN(k) && IN((k) + 1)) xcd_barrier(bar); } while (0)
#define PHASE_PTRS unsigned char* const wsp = opaque_global(F.ws); float* const xout = opaque_global(args.out); \
    bf16_t* const XB = (bf16_t*)(wsp + WS_XB); float* const STATX = (float*)(wsp + WS_STATX); float* const STATC = (float*)(wsp + WS_STATC); bf16_t* const ACT = (bf16_t*)(wsp + WS_ACT); \
    unsigned char* const wl = wsp + WS_W + (size_t)l * W_LAYER; (void)XB; (void)STATX; (void)STATC; (void)ACT; (void)wl; (void)xout
template <int L_> __device__ __forceinline__ void layer_body(Frame& F, const Args& args, const XcdBarrier& bar, const int lo, const int hi) {
    constexpr int l = L_;
        const int pb = PH_L0 + l * PH_PER_LAYER;
        if (IN(pb + L_GU1)) { PHASE_PTRS;
            pg8::Gemm g{XB, (const bf16_t*)(wl + W_GU1), M, 2 * FF, DM, DM}; pg8::StaticOrder S; S.SINIT(M, 2 * FF, F.G, opaque_bx());
            constexpr bool f8 = d_is_f8(l, 0); constexpr bool gf8 = gu_is_f8(l, 0);
            if constexpr (gf8) {
                pg8::Gemm g8{(const bf16_t*)xout, (const bf16_t*)(wl + W_GU1), M, 2 * FF, DM / 2, DM / 2};
                pg8::EpiSwiGLU<f8> E{(unsigned char*)ACT, STATX, (LAS float*)(F.lds + pg8::RS_TAB_OFF), 1.0f / (X_F8_SCALE * WGU_F8_SCALE)};
                pg8::gemm_phase<pg8::EpiSwiGLU<f8>, pg8::StaticOrder, true, true, true>(F.lds + RING_OFF, g8, S, E);
            } else {
            pg8::EpiSwiGLU<f8> E{(unsigned char*)ACT, STATX, (LAS float*)(F.lds + pg8::RS_TAB_OFF), 1.0f};
            for (int rep = 0; rep < NREP(L_GU1); ++rep)
            pg8::gemm_phase<pg8::EpiSwiGLU<f8>, pg8::StaticOrder, true, true>(F.lds + RING_OFF, g, S, E);
            }
            SEAM(pb + L_GU1);
        }
        if (IN(pb + L_D1)) { PHASE_PTRS;
            constexpr bool f8 = d_is_f8(l, 0); constexpr int KD = f8 ? FF / 2 : FF;
            pg8::Gemm g{ACT, (const bf16_t*)(wl + W_D1), M, DM, KD, KD}; pg8::StaticOrder S; S.SINIT(M, DM, F.G, opaque_bx());
            pg8::EpiResid E{XB, STATX, f8 ? 0.5f / (ACT_F8_SCALE * WD_F8_SCALE) : 0.5f, win_is_f8(l) ? (unsigned char*)xout + DOUT_XB8 : nullptr};
            pg8::gemm_phase<pg8::EpiResid, pg8::StaticOrder, true, true, f8>(F.lds + RING_OFF, g, S, E);
            if (NREP(L_D1) == 2) { pg8::EpiResid E2{XB, STATX, 0.0f}; __syncthreads(); pg8::gemm_phase<pg8::EpiResid, pg8::StaticOrder, true, true, f8>(F.lds + RING_OFF, g, S, E2); }
            SEAM(pb + L_D1);
        }
        if (IN(pb + L_WIN)) { PHASE_PTRS;
            if constexpr (win_is_f8(l)) {
                { pg8::Gemm g8{(const bf16_t*)((unsigned char*)xout + DOUT_XB8), (const bf16_t*)(wl + W_IN), M, WIN_F8_TILES * 256, DM / 2, DM / 2}; pg8::StaticOrder S; S.SINIT(M, WIN_F8_TILES * 256, F.G, opaque_bx());
                  pg8::EpiScatter<true> E{WIN_DESC, wsp, STATX, 16, 0, 16, 1.0f / 1024.0f, STATC, (LAS float*)(F.lds + pg8::RS_TAB_OFF), 0, 1.0f / (X_F8_SCALE * WIN_F8_SCALE)};
                  pg8::gemm_phase<pg8::EpiScatter<true>, pg8::StaticOrder, true, true, true>(F.lds + RING_OFF, g8, S, E); }
                __syncthreads();
                { pg8::Gemm gb{XB, (const bf16_t*)(wl + W_IN) + (size_t)WIN_F8_TILES * 256 * DM, M, NIN - WIN_F8_TILES * 256, DM, DM}; pg8::StaticOrder S; S.SINIT(M, NIN - WIN_F8_TILES * 256, F.G, opaque_bx());
                  pg8::EpiScatter<true> E{WIN_DESC, wsp, STATX, 16, 0, 16, 1.0f / 1024.0f, STATC, (LAS float*)(F.lds + pg8::RS_TAB_OFF), WIN_F8_TILES, 1.0f};
                  pg8::gemm_phase<pg8::EpiScatter<true>, pg8::StaticOrder, true, true>(F.lds + RING_OFF, gb, S, E); }
            } else {
            pg8::Gemm g{XB, (const bf16_t*)(wl + W_IN), M, NIN, DM, DM}; pg8::StaticOrder S; S.SINIT(M, NIN, F.G, opaque_bx());
            pg8::EpiScatter<true> E{WIN_DESC, wsp, STATX, 16, 0, 16, 1.0f / 1024.0f, STATC, (LAS float*)(F.lds + pg8::RS_TAB_OFF)};
            for (int rep = 0; rep < NREP(L_WIN); ++rep)
            pg8::gemm_phase<pg8::EpiScatter<true>, pg8::StaticOrder, true, true>(F.lds + RING_OFF, g, S, E);
            }
            SEAM(pb + L_WIN);
        }
        if (IN(pb + L_MIXA)) { PHASE_PTRS;
#if !defined(DBG_NO_C)
            const bool mla_split = (F.G == 2 * (M / pg8::BM)); const int mla_pm = F.vcu >> 1, mla_kind = F.vcu & 1;
            if (!mla_split || mla_kind == 0)
            { pg8::Gemm g{(const bf16_t*)(wsp + WS_CQ), (const bf16_t*)(wl + W_UQ), M, 512, 384, 384}; pg8::StaticOrder S; if (mla_split) S.init_panel(M, 512, mla_pm); else S.SINIT(M, 512, F.G, opaque_bx());
              pg8::EpiScatter<false> E{WUQ_DESC, wsp, STATC, 32, 0, 12, 1.0f / 384.0f, nullptr, (LAS float*)(F.lds + pg8::RS_TAB_OFF)};
              pg8::gemm_phase<pg8::EpiScatter<false>, pg8::StaticOrder, true, true>(F.lds + RING_OFF, g, S, E); }
            if (!mla_split || mla_kind == 1)
            { pg8::Gemm g{(const bf16_t*)(wsp + WS_CKV), (const bf16_t*)(wl + W_UKV), M, 768, 256, 256}; pg8::StaticOrder S; if (mla_split) S.init_panel(M, 768, mla_pm); else S.SINIT(M, 768, F.G, opaque_bx());
              pg8::EpiScatter<false> E{WUKV_DESC, wsp, STATC, 32, 16, 8, 1.0f / 256.0f, nullptr, (LAS float*)(F.lds + pg8::RS_TAB_OFF)};
              pg8::gemm_phase<pg8::EpiScatter<false>, pg8::StaticOrder, true, true>(F.lds + RING_OFF, g, S, E); }
#endif
            const float* biasl = args.in.p[7] + l * 6 * 192; unsigned* const bml = (unsigned*)(wsp + WS_BM) + (size_t)l * (8u << 20);
            for (int rep = 0; rep < NREP(L_MIXA); ++rep)
            for (;;) {
                const int it = queue_next(F, 2 * l + 8 * rep);
                if (it >= 1024 + 768) break;
                if (it < 1024) {
#if !defined(DBG_NO_B)
                    sel::sel_unit(F, it & 3, 255 - (it >> 2), bml, (const bf16_t*)(wl + W_IW));
#endif
                } else {
                    const int i2 = it - 1024, r = i2 % 24;
#if !defined(DBG_NO_A)
                    att::attn_unit<0>(F, r / 6, r % 6, 31 - i2 / 24, biasl, nullptr, rep == 0, wo_is_f8(l) ? (unsigned char*)xout + DOUT_O8 : nullptr);
#else
                    zero_o(F, r / 6, 31 - i2 / 24, 64 * (r % 6));
#endif
                }
            }
            SEAM(pb + L_MIXA);
        }
        if (IN(pb + L_MIXB)) { PHASE_PTRS;
            const unsigned* const bml = (const unsigned*)(wsp + WS_BM) + (size_t)l * (8u << 20);
            for (int rep = 0; rep < NREP(L_MIXB); ++rep)
            for (;;) {
                const int it = queue_next(F, 2 * l + 1 + 8 * rep);
                if (it >= 1280) break;
                const int qb = 31 - it / 40, r = it % 40, r2 = r % 20;
                if (rep == 1 && ((PROBE_DUP == 41 && r >= 20) || (PROBE_DUP == 42 && r < 20))) continue;
                if (r < 20) {
#if !defined(DBG_NO_C)
                    att::attn_unit<2>(F, r2 / 5, r2 % 5, qb, nullptr, nullptr, rep == 0, wo_is_f8(l) ? (unsigned char*)xout + DOUT_O8 : nullptr);
#else
                    zero_o(F, r2 / 5, qb, 704 + 64 * (r2 % 5));
#endif
                } else {
#if !defined(DBG_NO_B) && !defined(DBG_NO_BATT)
                    att::attn_unit<1>(F, r2 / 5, r2 % 5, qb, nullptr, bml, rep == 0, wo_is_f8(l) ? (unsigned char*)xout + DOUT_O8 : nullptr);
#else
                    zero_o(F, r2 / 5, qb, 384 + 64 * (r2 % 5));
#endif
                }
            }
            SEAM(pb + L_MIXB);
        }
        if (IN(pb + L_WOUT)) { PHASE_PTRS;
            constexpr bool of8 = wo_is_f8(l);
            pg8::Gemm g{of8 ? (const bf16_t*)((unsigned char*)xout + DOUT_O8) : (const bf16_t*)(wsp + WS_QO), (const bf16_t*)(wl + W_OUT), M, DM, of8 ? DM / 2 : DM, of8 ? DM / 2 : QO_PITCH}; pg8::StaticOrder S; S.SINIT(M, DM, F.G, opaque_bx());
            pg8::EpiResid E{XB, STATX, of8 ? 1.0f / (O_F8_SCALE * WO_F8_SCALE) : 1.0f, gu_is_f8(l, 1) ? (unsigned char*)xout + DOUT_XB8 : nullptr};
            pg8::gemm_phase<pg8::EpiResid, pg8::StaticOrder, true, true, of8>(F.lds + RING_OFF, g, S, E);
            if (NREP(L_WOUT) == 2) { pg8::EpiResid E2{XB, STATX, 0.0f}; __syncthreads(); pg8::gemm_phase<pg8::EpiResid, pg8::StaticOrder, true, true>(F.lds + RING_OFF, g, S, E2); }
            if (PROBE_DUP == 200) { for (int rep = 0; rep < 8; ++rep) xcd_barrier(bar); }
            SEAM(pb + L_WOUT);
        }
        if (IN(pb + L_GU2)) { PHASE_PTRS;
            pg8::Gemm g{XB, (const bf16_t*)(wl + W_GU2), M, 2 * FF, DM, DM}; pg8::StaticOrder S; S.SINIT(M, 2 * FF, F.G, opaque_bx());
            constexpr bool f8 = d_is_f8(l, 1); constexpr bool gf8 = gu_is_f8(l, 1);
            if constexpr (gf8) {
                pg8::Gemm g8{(const bf16_t*)xout, (const bf16_t*)(wl + W_GU2), M, 2 * FF, DM / 2, DM / 2};
                pg8::EpiSwiGLU<f8> E{(unsigned char*)ACT, STATX, (LAS float*)(F.lds + pg8::RS_TAB_OFF), 1.0f / (X_F8_SCALE * WGU_F8_SCALE)};
                pg8::gemm_phase<pg8::EpiSwiGLU<f8>, pg8::StaticOrder, true, true, true>(F.lds + RING_OFF, g8, S, E);
            } else {
            pg8::EpiSwiGLU<f8> E{(unsigned char*)ACT, STATX, (LAS float*)(F.lds + pg8::RS_TAB_OFF), 1.0f};
            pg8::gemm_phase<pg8::EpiSwiGLU<f8>, pg8::StaticOrder, true, true>(F.lds + RING_OFF, g, S, E);
            }
            SEAM(pb + L_GU2);
        }
        if (IN(pb + L_D2)) { PHASE_PTRS;
            constexpr bool f8 = d_is_f8(l, 1); constexpr int KD = f8 ? FF / 2 : FF;
            pg8::Gemm g{ACT, (const bf16_t*)(wl + W_D2), M, DM, KD, KD}; pg8::StaticOrder S; S.SINIT(M, DM, F.G, opaque_bx());
            pg8::EpiResid E{XB, STATX, f8 ? 0.5f / (ACT_F8_SCALE * WD_F8_SCALE) : 0.5f, (l + 1 < DEPTH && gu_is_f8(l + 1 < DEPTH ? l + 1 : l, 0)) ? (unsigned char*)xout : nullptr};
            pg8::gemm_phase<pg8::EpiResid, pg8::StaticOrder, true, true, f8>(F.lds + RING_OFF, g, S, E);
            SEAM(pb + L_D2);
        }
}
__global__ void __launch_bounds__(NWAVES * 64, 2) fwd_kernel(Args args) {
    extern __shared__ __attribute__((aligned(16))) unsigned char lds[];
    Frame F;
    F.lds = (LAS unsigned char*)lds;
    F.MISC = (volatile LAS unsigned*)(F.lds + MISC_OFF);
    F.wave = __builtin_amdgcn_readfirstlane((int)threadIdx.x >> 6);
    F.G = gridDim.x; { const int bx = blockIdx.x; F.vcu = (F.G % 8 == 0) ? (bx % 8) * (F.G / 8) + bx / 8 : bx; }
    F.ws = args.ws; F.ctl = (gu32*)(args.ws + WS_CTL);
    for (int u = threadIdx.x; u < (LDS_BYTES - LDSCTL_OFF) / 4; u += NWAVES * 64) ((LAS unsigned*)(F.lds + LDSCTL_OFF))[u] = 0u;
    __syncthreads();
    XcdBarrier bar; bar.bar = (unsigned*)(F.ctl + CW_BAR); bar.x = 0; bar.st = nullptr;
    if (args.ph_hi - args.ph_lo > 1) bar = xcd_barrier_post((unsigned*)(F.ctl + CW_BAR), F.MISC + 8);
    const int lo = args.ph_lo, hi = args.ph_hi;

    if (IN(PH_PRO)) { for (int rep = 0; rep < NREP(100); ++rep) { p0_prologue(F, args.in); __syncthreads(); } SEAM(PH_PRO); }

    static_assert(DEPTH == 2, "layer instantiations");
    layer_body<0>(F, args, bar, lo, hi);
    layer_body<1>(F, args, bar, lo, hi);
    if (IN(PH_FNORM)) final_norm(F, args.out, args.in.p[17]);
#undef IN
#undef SEAM
}

extern "C" void kernel_launch(void* const* d_in, const int* in_sizes, int n_in, void* d_out, int out_size, void* d_ws, size_t ws_size, hipStream_t stream) {
    static int grid = 0;
    if (grid == 0) {
        if (n_in != 18 || in_sizes[0] != M * DM || out_size != M * DM || ws_size < WS_END) { fprintf(stderr, "kernel_launch: unexpected shapes / workspace (n_in %d, ws %zu, need %zu); nothing launched\n", n_in, ws_size, (size_t)WS_END); grid = -1; return; }
        int dev = 0, cus = 0, per_cu = 0;
        if (hipGetDevice(&dev) != hipSuccess || hipDeviceGetAttribute(&cus, hipDeviceAttributeMultiprocessorCount, dev) != hipSuccess) { grid = -1; return; }
        if (hipFuncSetAttribute((const void*)fwd_kernel, hipFuncAttributeMaxDynamicSharedMemorySize, LDS_BYTES) != hipSuccess) { fprintf(stderr, "kernel_launch: hipFuncSetAttribute failed\n"); grid = -1; return; }
        if (hipOccupancyMaxActiveBlocksPerMultiprocessor(&per_cu, (const void*)fwd_kernel, NWAVES * 64, LDS_BYTES) != hipSuccess || per_cu < 1) { fprintf(stderr, "kernel_launch: occupancy query says %d blocks per CU\n", per_cu); }
        (void)hipGetLastError();
        grid = cus;
    }
    if (grid < 0) return;
    if (hipMemsetAsync((char*)d_ws + WS_CTL, 0, CTL_ZERO_BYTES, stream) != hipSuccess) return;
    Args a{};
    for (int i = 0; i < 18; ++i) a.in.p[i] = (const float*)d_in[i];
    a.out = (float*)d_out; a.ws = (unsigned char*)d_ws;
#if MK_ONE_LAUNCH
    a.ph_lo = 0; a.ph_hi = NPH;
    hipLaunchKernelGGL(fwd_kernel, dim3(grid), dim3(NWAVES * 64), LDS_BYTES, stream, a);
#else
    for (int ph = 0; ph < NPH; ++ph) {
        a.ph_lo = ph; a.ph_hi = ph + 1;
        hipLaunchKernelGGL(fwd_kernel, dim3(grid), dim3(NWAVES * 64), LDS_BYTES, stream, a);
    }
#endif
}
```

```cpp
#include <hip/hip_runtime.h>
#include <cstdio>
#include <cstdint>

#define LAS __attribute__((address_space(3)))
#define GAS __attribute__((address_space(1)))
typedef unsigned short bf16_t;
typedef short bf16x8 __attribute__((ext_vector_type(8)));
typedef short s16x4 __attribute__((ext_vector_type(4)));
typedef float f32x4 __attribute__((ext_vector_type(4)));
typedef float f32x2 __attribute__((ext_vector_type(2)));
typedef float f32x16 __attribute__((ext_vector_type(16)));
typedef unsigned u32x4 __attribute__((ext_vector_type(4)));
typedef unsigned u32x2 __attribute__((ext_vector_type(2)));
typedef unsigned u32x16 __attribute__((ext_vector_type(16)));

constexpr int BATCH = 4, SEQ = 8192, DM = 1024, DEPTH = 2, FF = 2816;
constexpr int M = BATCH * SEQ;
constexpr int NIN = 3072;
constexpr float EPS = 1e-6f;
constexpr float LOG2E = 1.4426950408889634f;
constexpr float C2_64 = 0.125f * LOG2E;
constexpr float C2_96 = 0.10206207261596575f * LOG2E;
constexpr int NWAVES = 8;
#ifndef F8_GU_MASK
#define F8_GU_MASK 0x8
#endif
#ifndef F8_D_MASK
#define F8_D_MASK 0xE
#endif
__host__ __device__ constexpr bool d_is_f8(int layer, int which  ) { return ((F8_D_MASK >> (2 * layer + which)) & 1) != 0; }
__host__ __device__ constexpr bool gu_is_f8(int layer, int which) { return ((F8_GU_MASK >> (2 * layer + which)) & 1) != 0 && (2 * layer + which) != 0; }
#ifndef F8_WIN_MASK
#define F8_WIN_MASK 0x0
#endif
__host__ __device__ constexpr bool win_is_f8(int layer) { return ((F8_WIN_MASK >> layer) & 1) != 0; }
constexpr int WIN_F8_TILES = 10; constexpr float WIN_F8_SCALE = 256.0f;
#ifndef F8_WO_MASK
#define F8_WO_MASK 0x2
#endif
__host__ __device__ constexpr bool wo_is_f8(int layer) { return ((F8_WO_MASK >> layer) & 1) != 0; }
constexpr float O_F8_SCALE = 128.0f, WO_F8_SCALE = 256.0f;
constexpr size_t DOUT_XB8 = 0, DOUT_O8 = 32u << 20;
constexpr float X_F8_SCALE = 16.0f, WGU_F8_SCALE = 256.0f;
constexpr float ACT_F8_SCALE = 4.0f, WD_F8_SCALE = 256.0f;

constexpr size_t MiB = 1u << 20;
constexpr size_t WS_CTL = 0, CTL_ZERO_BYTES = 1 * MiB;
constexpr size_t WS_W = 1 * MiB, W_LAYER = 43 * MiB;
constexpr size_t W_GU1 = 0, W_D1 = 11 * MiB, W_IN = 16 * MiB + MiB / 2, W_UQ = 23 * MiB, W_IW = 23 * MiB + 448 * 1024  , W_UKV = 23 * MiB + MiB / 2, W_OUT = 24 * MiB, W_GU2 = 26 * MiB, W_D2 = 37 * MiB;
constexpr size_t WS_TAB64 = 87 * MiB, WS_TAB32 = 89 * MiB;
constexpr size_t WS_XB = 90 * MiB;
constexpr size_t WS_STATX = 154 * MiB;
constexpr size_t WS_STATC = 156 * MiB;
constexpr size_t WS_U = 160 * MiB;
constexpr size_t WS_ACT = WS_U;
constexpr size_t WS_QO = WS_U, WS_KA = WS_U + 74 * MiB, WS_VA = WS_U + 98 * MiB, WS_KB = WS_U + 122 * MiB, WS_VB = WS_U + 142 * MiB, WS_IQ = WS_U + 162 * MiB,
                 WS_IK = WS_U + 178 * MiB, WS_IW = WS_U + 180 * MiB, WS_CQ = WS_U + 182 * MiB, WS_CKV = WS_U + 206 * MiB, WS_KN = WS_U + 222 * MiB, WS_VC = WS_U + 242 * MiB,
                 WS_KR = WS_U + 262 * MiB, WS_BM = WS_U + 264 * MiB  , WS_END = WS_U + 328 * MiB;
constexpr int QO_PITCH = 1184;
static_assert(WS_ACT + (size_t)M * FF * 2 <= WS_END && WS_QO + (size_t)M * QO_PITCH * 2 <= WS_KA, "ws map");
constexpr int CW_BAR = 4096;
constexpr int CW_Q = 16384;

enum { B_QO, B_KA, B_VA, B_KB, B_VB, B_IQ, B_IK, B_IW, B_CQ, B_CKV, B_KN, B_VC, B_KR, B_NBUF };
__device__ const unsigned long long BUF_OFF[B_NBUF] = { WS_QO, WS_KA, WS_VA, WS_KB, WS_VB, WS_IQ, WS_IK, WS_IW, WS_CQ, WS_CKV, WS_KN, WS_VC, WS_KR };
__device__ const int BUF_PITCH[B_NBUF] = { QO_PITCH, 384, 384, 320, 320, 256, 32, 16, 384, 256, 320, 320, 32 };
struct Desc { short buf0, buf1, col0, col1, rope, j0, stat0, stat1, scale0, scale1, f32; };
__device__ const short WIN_SRC[3072] = {
 1152,1153,1154,1155,1156,1157,1158,1159,1160,1161,1162,1163,1164,1165,1166,1167,1168,1169,1170,1171,1172,1173,1174,1175,1176,1177,1178,1179,1180,1181,1182,1183,
 1216,1217,1218,1219,1220,1221,1222,1223,1224,1225,1226,1227,1228,1229,1230,1231,1232,1233,1234,1235,1236,1237,1238,1239,1240,1241,1242,1243,1244,1245,1246,1247,
 1280,1281,1282,1283,1284,1285,1286,1287,1288,1289,1290,1291,1292,1293,1294,1295,1296,1297,1298,1299,1300,1301,1302,1303,1304,1305,1306,1307,1308,1309,1310,1311,
 1344,1345,1346,1347,1348,1349,1350,1351,1352,1353,1354,1355,1356,1357,1358,1359,1360,1361,1362,1363,1364,1365,1366,1367,1368,1369,1370,1371,1372,1373,1374,1375,
 1184,1185,1186,1187,1188,1189,1190,1191,1192,1193,1194,1195,1196,1197,1198,1199,1200,1201,1202,1203,1204,1205,1206,1207,1208,1209,1210,1211,1212,1213,1214,1215,
 1248,1249,1250,1251,1252,1253,1254,1255,1256,1257,1258,1259,1260,1261,1262,1263,1264,1265,1266,1267,1268,1269,1270,1271,1272,1273,1274,1275,1276,1277,1278,1279,
 1312,1313,1314,1315,1316,1317,1318,1319,1320,1321,1322,1323,1324,1325,1326,1327,1328,1329,1330,1331,1332,1333,1334,1335,1336,1337,1338,1339,1340,1341,1342,1343,
 1376,1377,1378,1379,1380,1381,1382,1383,1384,1385,1386,1387,1388,1389,1390,1391,1392,1393,1394,1395,1396,1397,1398,1399,1400,1401,1402,1403,1404,1405,1406,1407,
 1408,1409,1410,1411,1412,1413,1414,1415,1416,1417,1418,1419,1420,1421,1422,1423,1424,1425,1426,1427,1428,1429,1430,1431,1432,1433,1434,1435,1436,1437,1438,1439,
 1472,1473,1474,1475,1476,1477,1478,1479,1480,1481,1482,1483,1484,1485,1486,1487,1488,1489,1490,1491,1492,1493,1494,1495,1496,1497,1498,1499,1500,1501,1502,1503,
 1536,1537,1538,1539,1540,1541,1542,1543,1544,1545,1546,1547,1548,1549,1550,1551,1552,1553,1554,1555,1556,1557,1558,1559,1560,1561,1562,1563,1564,1565,1566,1567,
 1600,1601,1602,1603,1604,1605,1606,1607,1608,1609,1610,1611,1612,1613,1614,1615,1616,1617,1618,1619,1620,1621,1622,1623,1624,1625,1626,1627,1628,1629,1630,1631,
 1440,1441,1442,1443,1444,1445,1446,1447,1448,1449,1450,1451,1452,1453,1454,1455,1456,1457,1458,1459,1460,1461,1462,1463,1464,1465,1466,1467,1468,1469,1470,1471,
 1504,1505,1506,1507,1508,1509,1510,1511,1512,1513,1514,1515,1516,1517,1518,1519,1520,1521,1522,1523,1524,1525,1526,1527,1528,1529,1530,1531,1532,1533,1534,1535,
 1568,1569,1570,1571,1572,1573,1574,1575,1576,1577,1578,1579,1580,1581,1582,1583,1584,1585,1586,1587,1588,1589,1590,1591,1592,1593,1594,1595,1596,1597,1598,1599,
 1632,1633,1634,1635,1636,1637,1638,1639,1640,1641,1642,1643,1644,1645,1646,1647,1648,1649,1650,1651,1652,1653,1654,1655,1656,1657,1658,1659,1660,1661,1662,1663,
 0,1,2,3,4,5,6,7,8,9,10,11,12,13,14,15,16,17,18,19,20,21,22,23,24,25,26,27,28,29,30,31,
 32,33,34,35,36,37,38,39,40,41,42,43,44,45,46,47,48,49,50,51,52,53,54,55,56,57,58,59,60,61,62,63,
 64,65,66,67,68,69,70,71,72,73,74,75,76,77,78,79,80,81,82,83,84,85,86,87,88,89,90,91,92,93,94,95,
 96,97,98,99,100,101,102,103,104,105,106,107,108,109,110,111,112,113,114,115,116,117,118,119,120,121,122,123,124,125,126,127,
 128,129,130,131,132,133,134,135,136,137,138,139,140,141,142,143,144,145,146,147,148,149,150,151,152,153,154,155,156,157,158,159,
 160,161,162,163,164,165,166,167,168,169,170,171,172,173,174,175,176,177,178,179,180,181,182,183,184,185,186,187,188,189,190,191,
 192,193,194,195,196,197,198,199,200,201,202,203,204,205,206,207,208,209,210,211,212,213,214,215,216,217,218,219,220,221,222,223,
 224,225,226,227,228,229,230,231,232,233,234,235,236,237,238,239,240,241,242,243,244,245,246,247,248,249,250,251,252,253,254,255,
 256,257,258,259,260,261,262,263,264,265,266,267,268,269,270,271,272,273,274,275,276,277,278,279,280,281,282,283,284,285,286,287,
 288,289,290,291,292,293,294,295,296,297,298,299,300,301,302,303,304,305,306,307,308,309,310,311,312,313,314,315,316,317,318,319,
 320,321,322,323,324,325,326,327,328,329,330,331,332,333,334,335,336,337,338,339,340,341,342,343,344,345,346,347,348,349,350,351,
 352,353,354,355,356,357,358,359,360,361,362,363,364,365,366,367,368,369,370,371,372,373,374,375,376,377,378,379,380,381,382,383,
 384,385,386,387,388,389,390,391,392,393,394,395,396,397,398,399,400,401,402,403,404,405,406,407,408,409,410,411,412,413,414,415,
 416,417,418,419,420,421,422,423,424,425,426,427,428,429,430,431,432,433,434,435,436,437,438,439,440,441,442,443,444,445,446,447,
 448,449,450,451,452,453,454,455,456,457,458,459,460,461,462,463,464,465,466,467,468,469,470,471,472,473,474,475,476,477,478,479,
 480,481,482,483,484,485,486,487,488,489,490,491,492,493,494,495,496,497,498,499,500,501,502,503,504,505,506,507,508,509,510,511,
 512,513,514,515,516,517,518,519,520,521,522,523,524,525,526,527,528,529,530,531,532,533,534,535,536,537,538,539,540,541,542,543,
 544,545,546,547,548,549,550,551,552,553,554,555,556,557,558,559,560,561,562,563,564,565,566,567,568,569,570,571,572,573,574,575,
 576,577,578,579,580,581,582,583,584,585,586,587,588,589,590,591,592,593,594,595,596,597,598,599,600,601,602,603,604,605,606,607,
 608,609,610,611,612,613,614,615,616,617,618,619,620,621,622,623,624,625,626,627,628,629,630,631,632,633,634,635,636,637,638,639,
 640,641,642,643,644,645,646,647,648,649,650,651,652,653,654,655,656,657,658,659,660,661,662,663,664,665,666,667,668,669,670,671,
 672,673,674,675,676,677,678,679,680,681,682,683,684,685,686,687,688,689,690,691,692,693,694,695,696,697,698,699,700,701,702,703,
 704,705,706,707,708,709,710,711,712,713,714,715,716,717,718,719,720,721,722,723,724,725,726,727,728,729,730,731,732,733,734,735,
 736,737,738,739,740,741,742,743,744,745,746,747,748,749,750,751,752,753,754,755,756,757,758,759,760,761,762,763,764,765,766,767,
 768,769,770,771,772,773,774,775,776,777,778,779,780,781,782,783,784,785,786,787,788,789,790,791,792,793,794,795,796,797,798,799,
 800,801,802,803,804,805,806,807,808,809,810,811,812,813,814,815,816,817,818,819,820,821,822,823,824,825,826,827,828,829,830,831,
 832,833,834,835,836,837,838,839,840,841,842,843,844,845,846,847,848,849,850,851,852,853,854,855,856,857,858,859,860,861,862,863,
 864,865,866,867,868,869,870,871,872,873,874,875,876,877,878,879,880,881,882,883,884,885,886,887,888,889,890,891,892,893,894,895,
 896,897,898,899,900,901,902,903,904,905,906,907,908,909,910,911,912,913,914,915,916,917,918,919,920,921,922,923,924,925,926,927,
 928,929,930,931,932,933,934,935,936,937,938,939,940,941,942,943,944,945,946,947,948,949,950,951,952,953,954,955,956,957,958,959,
 960,961,962,963,964,965,966,967,968,969,970,971,972,973,974,975,976,977,978,979,980,981,982,983,984,985,986,987,988,989,990,991,
 992,993,994,995,996,997,998,999,1000,1001,1002,1003,1004,1005,1006,1007,1008,1009,1010,1011,1012,1013,1014,1015,1016,1017,1018,1019,1020,1021,1022,1023,
 1024,1025,1026,1027,1028,1029,1030,1031,1032,1033,1034,1035,1036,1037,1038,1039,1040,1041,1042,1043,1044,1045,1046,1047,1048,1049,1050,1051,1052,1053,1054,1055,
 1056,1057,1058,1059,1060,1061,1062,1063,1064,1065,1066,1067,1068,1069,1070,1071,1072,1073,1074,1075,1076,1077,1078,1079,1080,1081,1082,1083,1084,1085,1086,1087,
 1088,1089,1090,1091,1092,1093,1094,1095,1096,1097,1098,1099,1100,1101,1102,1103,1104,1105,1106,1107,1108,1109,1110,1111,1112,1113,1114,1115,1116,1117,1118,1119,
 1120,1121,1122,1123,1124,1125,1126,1127,1128,1129,1130,1131,1132,1133,1134,1135,1136,1137,1138,1139,1140,1141,1142,1143,1144,1145,1146,1147,1148,1149,1150,1151,
 1792,1793,1794,1795,1796,1797,1798,1799,1800,1801,1802,1803,1804,1805,1806,1807,1808,1809,1810,1811,1812,1813,1814,1815,1816,1817,1818,1819,1820,1821,1822,1823,
 1824,1825,1826,1827,1828,1829,1830,1831,1832,1833,1834,1835,1836,1837,1838,1839,1840,1841,1842,1843,1844,1845,1846,1847,1848,1849,1850,1851,1852,1853,1854,1855,
 1856,1857,1858,1859,1860,1861,1862,1863,1864,1865,1866,1867,1868,1869,1870,1871,1872,1873,1874,1875,1876,1877,1878,1879,1880,1881,1882,1883,1884,1885,1886,1887,
 1888,1889,1890,1891,1892,1893,1894,1895,1896,1897,1898,1899,1900,1901,1902,1903,1904,1905,1906,1907,1908,1909,1910,1911,1912,1913,1914,1915,1916,1917,1918,1919,
 1920,1921,1922,1923,1924,1925,1926,1927,1928,1929,1930,1931,1932,1933,1934,1935,1936,1937,1938,1939,1940,1941,1942,1943,1944,1945,1946,1947,1948,1949,1950,1951,
 1952,1953,1954,1955,1956,1957,1958,1959,1960,1961,1962,1963,1964,1965,1966,1967,1968,1969,1970,1971,1972,1973,1974,1975,1976,1977,1978,1979,1980,1981,1982,1983,
 1984,1985,1986,1987,1988,1989,1990,1991,1992,1993,1994,1995,1996,1997,1998,1999,2000,2001,2002,2003,2004,2005,2006,2007,2008,2009,2010,2011,2012,2013,2014,2015,
 2016,2017,2018,2019,2020,2021,2022,2023,2024,2025,2026,2027,2028,2029,2030,2031,2032,2033,2034,2035,2036,2037,2038,2039,2040,2041,2042,2043,2044,2045,2046,2047,
 2408,2409,2410,2411,2412,2413,2414,2415,2416,2417,2418,2419,2420,2421,2422,2423,2424,2425,2426,2427,2428,2429,2430,2431,2432,2433,2434,2435,2436,2437,2438,2439,
 2440,2441,2442,2443,2444,2445,2446,2447,2448,2449,2450,2451,2452,2453,2454,2455,2456,2457,2458,2459,2460,2461,2462,2463,2464,2465,2466,2467,2468,2469,2470,2471,
 2472,2473,2474,2475,2476,2477,2478,2479,2480,2481,2482,2483,2484,2485,2486,2487,2488,2489,2490,2491,2492,2493,2494,2495,2496,2497,2498,2499,2500,2501,2502,2503,
 2504,2505,2506,2507,2508,2509,2510,2511,2512,2513,2514,2515,2516,2517,2518,2519,2520,2521,2522,2523,2524,2525,2526,2527,2528,2529,2530,2531,2532,2533,2534,2535,
 2536,2537,2538,2539,2540,2541,2542,2543,2544,2545,2546,2547,2548,2549,2550,2551,2552,2553,2554,2555,2556,2557,2558,2559,2560,2561,2562,2563,2564,2565,2566,2567,
 2568,2569,2570,2571,2572,2573,2574,2575,2576,2577,2578,2579,2580,2581,2582,2583,2584,2585,2586,2587,2588,2589,2590,2591,2592,2593,2594,2595,2596,2597,2598,2599,
 2600,2601,2602,2603,2604,2605,2606,2607,2608,2609,2610,2611,2612,2613,2614,2615,2616,2617,2618,2619,2620,2621,2622,2623,2624,2625,2626,2627,2628,2629,2630,2631,
 2632,2633,2634,2635,2636,2637,2638,2639,2640,2641,2642,2643,2644,2645,2646,2647,2648,2649,2650,2651,2652,2653,2654,2655,2656,2657,2658,2659,2660,2661,2662,2663,
 2664,2665,2666,2667,2668,2669,2670,2671,2672,2673,2674,2675,2676,2677,2678,2679,2680,2681,2682,2683,2684,2685,2686,2687,2688,2689,2690,2691,2692,2693,2694,2695,
 2696,2697,2698,2699,2700,2701,2702,2703,2704,2705,2706,2707,2708,2709,2710,2711,2712,2713,2714,2715,2716,2717,2718,2719,2720,2721,2722,2723,2724,2725,2726,2727,
 2728,2729,2730,2731,2732,2733,2734,2735,2736,2737,2738,2739,2740,2741,2742,2743,2744,2745,2746,2747,2748,2749,2750,2751,2752,2753,2754,2755,2756,2757,2758,2759,
 2760,2761,2762,2763,2764,2765,2766,2767,2768,2769,2770,2771,2772,2773,2774,2775,2776,2777,2778,2779,2780,2781,2782,2783,2784,2785,2786,2787,2788,2789,2790,2791,
 2792,2793,2794,2795,2796,2797,2798,2799,2800,2801,2802,2803,2804,2805,2806,2807,2808,2809,2810,2811,2812,2813,2814,2815,2816,2817,2818,2819,2820,2821,2822,2823,
 2824,2825,2826,2827,2828,2829,2830,2831,2832,2833,2834,2835,2836,2837,2838,2839,2840,2841,2842,2843,2844,2845,2846,2847,2848,2849,2850,2851,2852,2853,2854,2855,
 2856,2857,2858,2859,2860,2861,2862,2863,2864,2865,2866,2867,2868,2869,2870,2871,2872,2873,2874,2875,2876,2877,2878,2879,2880,2881,2882,2883,2884,2885,2886,2887,
 2888,2889,2890,2891,2892,2893,2894,2895,2896,2897,2898,2899,2900,2901,2902,2903,2904,2905,2906,2907,2908,2909,2910,2911,2912,2913,2914,2915,2916,2917,2918,2919,
 2920,2921,2922,2923,2924,2925,2926,2927,2928,2929,2930,2931,2932,2933,2934,2935,2936,2937,2938,2939,2940,2941,2942,2943,2944,2945,2946,2947,2948,2949,2950,2951,
 2952,2953,2954,2955,2956,2957,2958,2959,2960,2961,2962,2963,2964,2965,2966,2967,2968,2969,2970,2971,2972,2973,2974,2975,2976,2977,2978,2979,2980,2981,2982,2983,
 2984,2985,2986,2987,2988,2989,2990,2991,2992,2993,2994,2995,2996,2997,2998,2999,3000,3001,3002,3003,3004,3005,3006,3007,3008,3009,3010,3011,3012,3013,3014,3015,
 3016,3017,3018,3019,3020,3021,3022,3023,3024,3025,3026,3027,3028,3029,3030,3031,3032,3033,3034,3035,3036,3037,3038,3039,3040,3041,3042,3043,3044,3045,3046,3047,
 1664,1665,1666,1667,1668,1669,1670,1671,1672,1673,1674,1675,1676,1677,1678,1679,1680,1681,1682,1683,1684,1685,1686,1687,1688,1689,1690,1691,1692,1693,1694,1695,
 1728,1729,1730,1731,1732,1733,1734,1735,1736,1737,1738,1739,1740,1741,1742,1743,1744,1745,1746,1747,1748,1749,1750,1751,1752,1753,1754,1755,1756,1757,1758,1759,
 2112,2113,2114,2115,2116,2117,2118,2119,2120,2121,2122,2123,2124,2125,2126,2127,2144,2145,2146,2147,2148,2149,2150,2151,2152,2153,2154,2155,2156,2157,2158,2159,
 2176,2177,2178,2179,2180,2181,2182,2183,2184,2185,2186,2187,2188,2189,2190,2191,2208,2209,2210,2211,2212,2213,2214,2215,2216,2217,2218,2219,2220,2221,2222,2223,
 1696,1697,1698,1699,1700,1701,1702,1703,1704,1705,1706,1707,1708,1709,1710,1711,1712,1713,1714,1715,1716,1717,1718,1719,1720,1721,1722,1723,1724,1725,1726,1727,
 1760,1761,1762,1763,1764,1765,1766,1767,1768,1769,1770,1771,1772,1773,1774,1775,1776,1777,1778,1779,1780,1781,1782,1783,1784,1785,1786,1787,1788,1789,1790,1791,
 2128,2129,2130,2131,2132,2133,2134,2135,2136,2137,2138,2139,2140,2141,2142,2143,2160,2161,2162,2163,2164,2165,2166,2167,2168,2169,2170,2171,2172,2173,2174,2175,
 2192,2193,2194,2195,2196,2197,2198,2199,2200,2201,2202,2203,2204,2205,2206,2207,2224,2225,2226,2227,2228,2229,2230,2231,2232,2233,2234,2235,2236,2237,2238,2239,
 2240,2241,2242,2243,2244,2245,2246,2247,2248,2249,2250,2251,2252,2253,2254,2255,2272,2273,2274,2275,2276,2277,2278,2279,2280,2281,2282,2283,2284,2285,2286,2287,
 2304,2305,2306,2307,2308,2309,2310,2311,2312,2313,2314,2315,2316,2317,2318,2319,2336,2337,2338,2339,2340,2341,2342,2343,2344,2345,2346,2347,2348,2349,2350,2351,
 2368,2369,2370,2371,2372,2373,2374,2375,2376,2377,2378,2379,2380,2381,2382,2383,3048,3049,3050,3051,3052,3053,3054,3055,3056,3057,3058,3059,3060,3061,3062,3063,
 2048,2049,2050,2051,2052,2053,2054,2055,2056,2057,2058,2059,2060,2061,2062,2063,2080,2081,2082,2083,2084,2085,2086,2087,2088,2089,2090,2091,2092,2093,2094,2095,
 2256,2257,2258,2259,2260,2261,2262,2263,2264,2265,2266,2267,2268,2269,2270,2271,2288,2289,2290,2291,2292,2293,2294,2295,2296,2297,2298,2299,2300,2301,2302,2303,
 2320,2321,2322,2323,2324,2325,2326,2327,2328,2329,2330,2331,2332,2333,2334,2335,2352,2353,2354,2355,2356,2357,2358,2359,2360,2361,2362,2363,2364,2365,2366,2367,
 2384,2385,2386,2387,2388,2389,2390,2391,2392,2393,2394,2395,2396,2397,2398,2399,3064,3065,3066,3067,3068,3069,3070,3071,3072,3073,3074,3075,3076,3077,3078,3079,
 2064,2065,2066,2067,2068,2069,2070,2071,2072,2073,2074,2075,2076,2077,2078,2079,2096,2097,2098,2099,2100,2101,2102,2103,2104,2105,2106,2107,2108,2109,2110,2111,
};
__device__ const Desc WIN_DESC[96] = {
  {0,0,384,416,1,0,-1,-1,1,1,0},
  {0,0,400,432,1,16,-1,-1,1,1,0},
  {0,0,448,480,1,0,-1,-1,1,1,0},
  {0,0,464,496,1,16,-1,-1,1,1,0},
  {0,0,512,544,1,0,-1,-1,1,1,0},
  {0,0,528,560,1,16,-1,-1,1,1,0},
  {0,0,576,608,1,0,-1,-1,1,1,0},
  {0,0,592,624,1,16,-1,-1,1,1,0},
  {0,0,640,672,1,0,-1,-1,1,1,0},
  {0,0,656,688,1,16,-1,-1,1,1,0},
  {3,3,0,32,1,0,-1,-1,0,0,0},
  {3,3,16,48,1,16,-1,-1,0,0,0},
  {3,3,64,96,1,0,-1,-1,0,0,0},
  {3,3,80,112,1,16,-1,-1,0,0,0},
  {3,3,128,160,1,0,-1,-1,0,0,0},
  {3,3,144,176,1,16,-1,-1,0,0,0},
  {0,0,0,128,0,0,-1,-1,1,1,0},
  {0,0,16,144,0,0,-1,-1,1,1,0},
  {0,0,32,160,0,0,-1,-1,1,1,0},
  {0,0,48,176,0,0,-1,-1,1,1,0},
  {0,0,64,192,0,0,-1,-1,1,1,0},
  {0,0,80,208,0,0,-1,-1,1,1,0},
  {0,0,96,224,0,0,-1,-1,1,1,0},
  {0,0,112,240,0,0,-1,-1,1,1,0},
  {0,1,256,0,0,0,-1,-1,1,0,0},
  {0,1,272,16,0,0,-1,-1,1,0,0},
  {0,1,288,32,0,0,-1,-1,1,0,0},
  {0,1,304,48,0,0,-1,-1,1,0,0},
  {0,1,320,64,0,0,-1,-1,1,0,0},
  {0,1,336,80,0,0,-1,-1,1,0,0},
  {0,1,352,96,0,0,-1,-1,1,0,0},
  {0,1,368,112,0,0,-1,-1,1,0,0},
  {1,1,128,256,0,0,-1,-1,0,0,0},
  {1,1,144,272,0,0,-1,-1,0,0,0},
  {1,1,160,288,0,0,-1,-1,0,0,0},
  {1,1,176,304,0,0,-1,-1,0,0,0},
  {1,1,192,320,0,0,-1,-1,0,0,0},
  {1,1,208,336,0,0,-1,-1,0,0,0},
  {1,1,224,352,0,0,-1,-1,0,0,0},
  {1,1,240,368,0,0,-1,-1,0,0,0},
  {2,2,0,128,0,0,-1,-1,0,0,0},
  {2,2,16,144,0,0,-1,-1,0,0,0},
  {2,2,32,160,0,0,-1,-1,0,0,0},
  {2,2,48,176,0,0,-1,-1,0,0,0},
  {2,2,64,192,0,0,-1,-1,0,0,0},
  {2,2,80,208,0,0,-1,-1,0,0,0},
  {2,2,96,224,0,0,-1,-1,0,0,0},
  {2,2,112,240,0,0,-1,-1,0,0,0},
  {2,4,256,0,0,0,-1,-1,0,0,0},
  {2,4,272,16,0,0,-1,-1,0,0,0},
  {2,4,288,32,0,0,-1,-1,0,0,0},
  {2,4,304,48,0,0,-1,-1,0,0,0},
  {2,4,320,64,0,0,-1,-1,0,0,0},
  {2,4,336,80,0,0,-1,-1,0,0,0},
  {2,4,352,96,0,0,-1,-1,0,0,0},
  {2,4,368,112,0,0,-1,-1,0,0,0},
  {4,8,128,0,0,0,-1,0,0,0,0},
  {4,8,144,16,0,0,-1,0,0,0,0},
  {4,8,160,32,0,0,-1,0,0,0,0},
  {4,8,176,48,0,0,-1,0,0,0,0},
  {4,8,192,64,0,0,-1,0,0,0,0},
  {4,8,208,80,0,0,-1,0,0,0,0},
  {4,8,224,96,0,0,-1,0,0,0,0},
  {4,8,240,112,0,0,-1,0,0,0,0},
  {8,8,128,256,0,0,4,8,0,0,0},
  {8,8,144,272,0,0,4,8,0,0,0},
  {8,8,160,288,0,0,4,8,0,0,0},
  {8,8,176,304,0,0,4,8,0,0,0},
  {8,8,192,320,0,0,4,8,0,0,0},
  {8,8,208,336,0,0,4,8,0,0,0},
  {8,8,224,352,0,0,4,8,0,0,0},
  {8,8,240,368,0,0,4,8,0,0,0},
  {9,9,0,128,0,0,16,20,0,0,0},
  {9,9,16,144,0,0,16,20,0,0,0},
  {9,9,32,160,0,0,16,20,0,0,0},
  {9,9,48,176,0,0,16,20,0,0,0},
  {9,9,64,192,0,0,16,20,0,0,0},
  {9,9,80,208,0,0,16,20,0,0,0},
  {9,9,96,224,0,0,16,20,0,0,0},
  {9,9,112,240,0,0,16,20,0,0,0},
  {3,3,192,224,1,0,-1,-1,0,0,0},
  {3,3,208,240,1,16,-1,-1,0,0,0},
  {3,3,256,288,1,0,-1,-1,0,0,0},
  {3,3,272,304,1,16,-1,-1,0,0,0},
  {5,5,0,16,2,0,-1,-1,0,0,0},
  {5,5,32,48,2,0,-1,-1,0,0,0},
  {5,5,64,80,2,0,-1,-1,0,0,0},
  {5,5,96,112,2,0,-1,-1,0,0,0},
  {5,5,128,144,2,0,-1,-1,0,0,0},
  {5,5,160,176,2,0,-1,-1,0,0,0},
  {5,5,192,208,2,0,-1,-1,0,0,0},
  {5,5,224,240,2,0,-1,-1,0,0,0},
  {6,6,0,16,2,0,-1,-1,0,0,0},
  {12,12,0,16,2,0,-1,-1,0,0,0},
  {4,4,256,272,0,0,-1,-1,0,0,0},
  {4,4,288,304,0,0,-1,-1,0,0,0},
};
__device__ const short WIW_SRC[32] = {
 2400,2401,2402,2403,2404,2405,2406,2407,-1,-1,-1,-1,-1,-1,-1,-1,-1,-1,-1,-1,-1,-1,-1,-1,-1,-1,-1,-1,-1,-1,-1,-1,
};
__device__ const short WUQ_SRC[512] = {
 0,1,2,3,4,5,6,7,8,9,10,11,12,13,14,15,16,17,18,19,20,21,22,23,24,25,26,27,28,29,30,31,
 32,33,34,35,36,37,38,39,40,41,42,43,44,45,46,47,48,49,50,51,52,53,54,55,56,57,58,59,60,61,62,63,
 96,97,98,99,100,101,102,103,104,105,106,107,108,109,110,111,112,113,114,115,116,117,118,119,120,121,122,123,124,125,126,127,
 128,129,130,131,132,133,134,135,136,137,138,139,140,141,142,143,144,145,146,147,148,149,150,151,152,153,154,155,156,157,158,159,
 192,193,194,195,196,197,198,199,200,201,202,203,204,205,206,207,208,209,210,211,212,213,214,215,216,217,218,219,220,221,222,223,
 224,225,226,227,228,229,230,231,232,233,234,235,236,237,238,239,240,241,242,243,244,245,246,247,248,249,250,251,252,253,254,255,
 288,289,290,291,292,293,294,295,296,297,298,299,300,301,302,303,304,305,306,307,308,309,310,311,312,313,314,315,316,317,318,319,
 320,321,322,323,324,325,326,327,328,329,330,331,332,333,334,335,336,337,338,339,340,341,342,343,344,345,346,347,348,349,350,351,
 64,65,66,67,68,69,70,71,72,73,74,75,76,77,78,79,160,161,162,163,164,165,166,167,168,169,170,171,172,173,174,175,
 256,257,258,259,260,261,262,263,264,265,266,267,268,269,270,271,352,353,354,355,356,357,358,359,360,361,362,363,364,365,366,367,
 448,449,450,451,452,453,454,455,456,457,458,459,460,461,462,463,384,385,386,387,388,389,390,391,392,393,394,395,396,397,398,399,
 400,401,402,403,404,405,406,407,408,409,410,411,412,413,414,415,416,417,418,419,420,421,422,423,424,425,426,427,428,429,430,431,
 80,81,82,83,84,85,86,87,88,89,90,91,92,93,94,95,176,177,178,179,180,181,182,183,184,185,186,187,188,189,190,191,
 272,273,274,275,276,277,278,279,280,281,282,283,284,285,286,287,368,369,370,371,372,373,374,375,376,377,378,379,380,381,382,383,
 464,465,466,467,468,469,470,471,472,473,474,475,476,477,478,479,432,433,434,435,436,437,438,439,440,441,442,443,444,445,446,447,
 -1,-1,-1,-1,-1,-1,-1,-1,-1,-1,-1,-1,-1,-1,-1,-1,-1,-1,-1,-1,-1,-1,-1,-1,-1,-1,-1,-1,-1,-1,-1,-1,
};
__device__ const Desc WUQ_DESC[16] = {
  {0,0,704,832,0,0,-1,-1,2,2,0},
  {0,0,720,848,0,0,-1,-1,2,2,0},
  {0,0,736,864,0,0,-1,-1,2,2,0},
  {0,0,752,880,0,0,-1,-1,2,2,0},
  {0,0,768,896,0,0,-1,-1,2,2,0},
  {0,0,784,912,0,0,-1,-1,2,2,0},
  {0,0,800,928,0,0,-1,-1,2,2,0},
  {0,0,816,944,0,0,-1,-1,2,2,0},
  {0,0,1024,1040,2,0,-1,-1,2,2,0},
  {0,0,1056,1072,2,0,-1,-1,2,2,0},
  {0,0,1088,1104,2,0,-1,-1,2,2,0},
  {0,0,1120,1136,2,0,-1,-1,2,2,0},
  {0,0,1152,1168,2,0,-1,-1,2,2,0},
  {0,0,960,1008,0,0,-1,-1,2,2,0},
  {0,-1,976,0,0,0,-1,-1,2,0,0},
  {0,-1,992,0,0,0,-1,-1,2,0,0},
};
__device__ const short WUKV_SRC[768] = {
 0,1,2,3,4,5,6,7,8,9,10,11,12,13,14,15,16,17,18,19,20,21,22,23,24,25,26,27,28,29,30,31,
 32,33,34,35,36,37,38,39,40,41,42,43,44,45,46,47,48,49,50,51,52,53,54,55,56,57,58,59,60,61,62,63,
 128,129,130,131,132,133,134,135,136,137,138,139,140,141,142,143,144,145,146,147,148,149,150,151,152,153,154,155,156,157,158,159,
 160,161,162,163,164,165,166,167,168,169,170,171,172,173,174,175,176,177,178,179,180,181,182,183,184,185,186,187,188,189,190,191,
 256,257,258,259,260,261,262,263,264,265,266,267,268,269,270,271,272,273,274,275,276,277,278,279,280,281,282,283,284,285,286,287,
 288,289,290,291,292,293,294,295,296,297,298,299,300,301,302,303,304,305,306,307,308,309,310,311,312,313,314,315,316,317,318,319,
 384,385,386,387,388,389,390,391,392,393,394,395,396,397,398,399,400,401,402,403,404,405,406,407,408,409,410,411,412,413,414,415,
 416,417,418,419,420,421,422,423,424,425,426,427,428,429,430,431,432,433,434,435,436,437,438,439,440,441,442,443,444,445,446,447,
 512,513,514,515,516,517,518,519,520,521,522,523,524,525,526,527,528,529,530,531,532,533,534,535,536,537,538,539,540,541,542,543,
 544,545,546,547,548,549,550,551,552,553,554,555,556,557,558,559,560,561,562,563,564,565,566,567,568,569,570,571,572,573,574,575,
 64,65,66,67,68,69,70,71,72,73,74,75,76,77,78,79,80,81,82,83,84,85,86,87,88,89,90,91,92,93,94,95,
 96,97,98,99,100,101,102,103,104,105,106,107,108,109,110,111,112,113,114,115,116,117,118,119,120,121,122,123,124,125,126,127,
 192,193,194,195,196,197,198,199,200,201,202,203,204,205,206,207,208,209,210,211,212,213,214,215,216,217,218,219,220,221,222,223,
 224,225,226,227,228,229,230,231,232,233,234,235,236,237,238,239,240,241,242,243,244,245,246,247,248,249,250,251,252,253,254,255,
 320,321,322,323,324,325,326,327,328,329,330,331,332,333,334,335,336,337,338,339,340,341,342,343,344,345,346,347,348,349,350,351,
 352,353,354,355,356,357,358,359,360,361,362,363,364,365,366,367,368,369,370,371,372,373,374,375,376,377,378,379,380,381,382,383,
 448,449,450,451,452,453,454,455,456,457,458,459,460,461,462,463,464,465,466,467,468,469,470,471,472,473,474,475,476,477,478,479,
 480,481,482,483,484,485,486,487,488,489,490,491,492,493,494,495,496,497,498,499,500,501,502,503,504,505,506,507,508,509,510,511,
 576,577,578,579,580,581,582,583,584,585,586,587,588,589,590,591,592,593,594,595,596,597,598,599,600,601,602,603,604,605,606,607,
 608,609,610,611,612,613,614,615,616,617,618,619,620,621,622,623,624,625,626,627,628,629,630,631,632,633,634,635,636,637,638,639,
 -1,-1,-1,-1,-1,-1,-1,-1,-1,-1,-1,-1,-1,-1,-1,-1,-1,-1,-1,-1,-1,-1,-1,-1,-1,-1,-1,-1,-1,-1,-1,-1,
 -1,-1,-1,-1,-1,-1,-1,-1,-1,-1,-1,-1,-1,-1,-1,-1,-1,-1,-1,-1,-1,-1,-1,-1,-1,-1,-1,-1,-1,-1,-1,-1,
 -1,-1,-1,-1,-1,-1,-1,-1,-1,-1,-1,-1,-1,-1,-1,-1,-1,-1,-1,-1,-1,-1,-1,-1,-1,-1,-1,-1,-1,-1,-1,-1,
 -1,-1,-1,-1,-1,-1,-1,-1,-1,-1,-1,-1,-1,-1,-1,-1,-1,-1,-1,-1,-1,-1,-1,-1,-1,-1,-1,-1,-1,-1,-1,-1,
};
__device__ const Desc WUKV_DESC[24] = {
  {10,10,0,128,0,0,-1,-1,0,0,0},
  {10,10,16,144,0,0,-1,-1,0,0,0},
  {10,10,32,160,0,0,-1,-1,0,0,0},
  {10,10,48,176,0,0,-1,-1,0,0,0},
  {10,10,64,192,0,0,-1,-1,0,0,0},
  {10,10,80,208,0,0,-1,-1,0,0,0},
  {10,10,96,224,0,0,-1,-1,0,0,0},
  {10,10,112,240,0,0,-1,-1,0,0,0},
  {10,11,256,64,0,0,-1,-1,0,0,0},
  {10,11,272,80,0,0,-1,-1,0,0,0},
  {10,11,288,96,0,0,-1,-1,0,0,0},
  {10,11,304,112,0,0,-1,-1,0,0,0},
  {11,11,0,128,0,0,-1,-1,0,0,0},
  {11,11,16,144,0,0,-1,-1,0,0,0},
  {11,11,32,160,0,0,-1,-1,0,0,0},
  {11,11,48,176,0,0,-1,-1,0,0,0},
  {11,-1,192,0,0,0,-1,-1,0,0,0},
  {11,-1,208,0,0,0,-1,-1,0,0,0},
  {11,-1,224,0,0,0,-1,-1,0,0,0},
  {11,-1,240,0,0,0,-1,-1,0,0,0},
  {11,-1,256,0,0,0,-1,-1,0,0,0},
  {11,-1,272,0,0,0,-1,-1,0,0,0},
  {11,-1,288,0,0,0,-1,-1,0,0,0},
  {11,-1,304,0,0,0,-1,-1,0,0,0},
};
__device__ const double INV64[32] = {1,0.74989420933245587,0.56234132519034907,0.42169650342858223,0.31622776601683794,0.23713737056616552,0.17782794100389229,0.1333521432163324,0.10000000000000001,0.074989420933245579,0.056234132519034911,0.042169650342858224,0.031622776601683791,0.023713737056616554,0.017782794100389229,0.013335214321633241,0.01,0.0074989420933245579,0.005623413251903491,0.0042169650342858229,0.0031622776601683794,0.0023713737056616554,0.0017782794100389228,0.0013335214321633241,0.001,0.00074989420933245586,0.0005623413251903491,0.00042169650342858224,0.00031622776601683794,0.00023713737056616554,0.00017782794100389227,0.0001333521432163324};
__device__ const double INV32[16] = {1,0.56234132519034907,0.31622776601683794,0.17782794100389229,0.10000000000000001,0.056234132519034911,0.031622776601683791,0.017782794100389229,0.01,0.005623413251903491,0.0031622776601683794,0.0017782794100389228,0.001,0.0005623413251903491,0.00031622776601683794,0.00017782794100389227};
namespace pg8 {
#define PG8_LAS __attribute__((address_space(3)))
constexpr int BM = 256, BK = 64, HALF = 128, HTB = HALF * BK * 2  , STAGE_BYTES = 8 * HTB, NXCD = 8, WGM = 8;

__host__ __device__ __forceinline__ int lds_byte(int r, int c) { const int st = (r >> 4) * 2 + (c >> 5), rr = r & 15, cc = c & 31, ob = rr * 64 + cc * 2; return st * 1024 + (ob ^ (((ob >> 9) & 1) << 5)); }
__host__ __device__ __forceinline__ void stage_rc(int b, int& R, int& C) { const int st = b / 1024, sb = b % 1024, swz = sb ^ (((sb >> 9) & 1) << 5); R = (st >> 1) * 16 + swz / 64; C = (st & 1) * 32 + (swz % 64) / 2; }
__host__ __device__ __forceinline__ int perm32(int rho) { const int n = rho >> 4, i = rho & 15; return 8 * (i >> 2) + 4 * n + (i & 3); }
struct Unit { int pm, pn; };
struct Gemm { const bf16_t* A; const bf16_t* Bt; int M, N, K, lda; };
struct StaticOrder {
    int nM, nN, nwg, G, c;
    int pan = 0, pan_pm = 0;
    int pair = 0;
    __host__ __device__ void init(int M, int N, int G_, int c_) { nM = M / BM; nN = N / BM; nwg = nM * nN; G = G_; c = c_; }
    __host__ __device__ void init_pair(int M, int N, int G_, int c_) { init(M, N, G_, c_); pair = (G_ == 2 * nM && G_ % 8 == 0) ? 1 : 0; }
    __host__ __device__ void init_panel(int M, int N, int pm) { init(M, N, 0, 0); pan = 1; pan_pm = pm; }
    __host__ __device__ bool next(int i, Unit& u) const {
        if (pan) { if (i >= nN) return false; u.pm = pan_pm; u.pn = i; return true; }
        if (pair) { const int vcu = (c % 8) * (G / 8) + c / 8, pn = 2 * i + (vcu & 1); if (pn >= nN) return false; u.pm = vcu >> 1; u.pn = pn; return true; }
        const long L = (long)i * G + c; if (L >= nwg) return false;
        int wgid = (int)L; { const int q = nwg / NXCD, r = nwg % NXCD, xcd = wgid % NXCD, off = wgid / NXCD; wgid = (xcd < r ? xcd * (q + 1) : r * (q + 1) + (xcd - r) * q) + off; }
        const int nig = WGM * nN, gid = wgid / nig, fm = gid * WGM, gsz = (nM - fm) < WGM ? (nM - fm) : WGM;
        u.pm = fm + ((wgid % nig) % gsz); u.pn = (wgid % nig) / gsz; return true;
    }
    __device__ __forceinline__ void a_ready(const Unit&) const {}
    __device__ __forceinline__ void done(const Unit&) const {}
};
typedef __bf16 bf16x2_t __attribute__((ext_vector_type(2)));
__device__ __forceinline__ unsigned cvt_pk_bf16(float lo, float hi) { const f32x2 v = {lo, hi}; return __builtin_bit_cast(unsigned, __builtin_convertvector(v, bf16x2_t)); }
typedef int i32x4_t __attribute__((ext_vector_type(4)));
typedef int i32x8_t __attribute__((ext_vector_type(8)));
template <class Epi, class Sched, bool ALIGN_EPI = false, bool SP2 = false, bool FP8 = false>
__device__ __forceinline__ void gemm_phase(PG8_LAS unsigned char* lds, const Gemm g, const Sched& S, const Epi& E) {
    int tid_ = threadIdx.x; asm volatile("" : "+v"(tid_));
    const int tid = tid_, wid = __builtin_amdgcn_readfirstlane(tid >> 6), lane = tid & 63, wr = wid >> 2, wc = wid & 3, fr = lane & 15, fq = lane >> 4;
    const int K = g.K, nt = K / BK;
    unsigned voffA[2], voffB[2];
#pragma unroll
    for (int i = 0; i < 2; ++i) { int R, C; stage_rc(tid * 16 + i * 8192, R, C); const int Rb = Epi::PERM ? ((R & ~31) + perm32(R & 31)) : R;
        voffA[i] = (unsigned)(R * g.lda + C) * 2u; voffB[i] = (unsigned)(Rb * K + C) * 2u; }
    const size_t kstep = (size_t)(BK * 2);
    const size_t hstepB = (size_t)HALF * K * 2, hstepA = (size_t)HALF * g.lda * 2;
    const size_t tstepB = 2 * hstepB, tstepA = 2 * hstepA;
    const unsigned ldsw = (unsigned)wid * 1024u;
    const int aoff = lds_byte(wr * 64 + fr, fq * 8), boff = lds_byte(wc * 32 + fr, fq * 8);
#define PG8_SA(b, h) (((b) * 2 + (h)) * HTB)
#define PG8_SB(b, h) ((4 + (b) * 2 + (h)) * HTB)
#define PG8_STAGE(bufoff, gbase, voff) do { _Pragma("unroll") for (int _i = 0; _i < 2; ++_i) \
        __builtin_amdgcn_global_load_lds((const unsigned*)((const char*)(gbase) + (voff)[_i]), (PG8_LAS unsigned*)(lds + (bufoff) + ldsw + _i * 8192), 16, 0, 0); } while (0)
#define PG8_LDA(dst, b, h) do { if constexpr (FP8) { _Pragma("unroll") for (int m = 0; m < 4; ++m) { const PG8_LAS unsigned char* p_ = lds + PG8_SA(b, h) + aoff + m * 2048; \
        dst##8[m] = __builtin_shufflevector(*(const PG8_LAS i32x4_t*)p_, *(const PG8_LAS i32x4_t*)(p_ + 1024), 0, 1, 2, 3, 4, 5, 6, 7); } } \
    else { _Pragma("unroll") for (int m = 0; m < 4; ++m) _Pragma("unroll") for (int k = 0; k < 2; ++k) dst[m][k] = *(const PG8_LAS bf16x8*)(lds + PG8_SA(b, h) + aoff + m * 2048 + k * 1024); } } while (0)
#define PG8_LDB(dst, b, h) do { if constexpr (FP8) { _Pragma("unroll") for (int n = 0; n < 2; ++n) { const PG8_LAS unsigned char* p_ = lds + PG8_SB(b, h) + boff + n * 2048; \
        dst##8[n] = __builtin_shufflevector(*(const PG8_LAS i32x4_t*)p_, *(const PG8_LAS i32x4_t*)(p_ + 1024), 0, 1, 2, 3, 4, 5, 6, 7); } } \
    else { _Pragma("unroll") for (int n = 0; n < 2; ++n) _Pragma("unroll") for (int k = 0; k < 2; ++k) dst[n][k] = *(const PG8_LAS bf16x8*)(lds + PG8_SB(b, h) + boff + n * 2048 + k * 1024); } } while (0)
#define PG8_MMA(ai, bj, At, Bt) do { __builtin_amdgcn_s_setprio(1); _Pragma("unroll") for (int m = 0; m < 4; ++m) _Pragma("unroll") for (int n = 0; n < 2; ++n) { \
        if constexpr (FP8) { asm volatile("v_mfma_scale_f32_16x16x128_f8f6f4 %0, %1, %2, %0, %3, %3 op_sel_hi:[0,0,0]" : "+v"(acc[ai][bj][m][n]) : "v"(Bt##8[n]), "v"(At##8[m]), "v"(f8scale)); }     \
        else { _Pragma("unroll") for (int k = 0; k < 2; ++k) acc[ai][bj][m][n] = __builtin_amdgcn_mfma_f32_16x16x32_bf16(Bt[n][k], At[m][k], acc[ai][bj][m][n], 0, 0, 0); } } \
        __builtin_amdgcn_s_setprio(0); } while (0)
#define PG8_WAIT_V(n) asm volatile("s_waitcnt vmcnt(" #n ")" ::: "memory")
#define PG8_WAIT_L(n) asm volatile("s_waitcnt lgkmcnt(" #n ")" ::: "memory")
#define PG8_BAR __builtin_amdgcn_s_barrier()
#define PG8_SCHED __builtin_amdgcn_sched_barrier(0)
    Unit cur, nxt; int ui = 0;
    if (!S.next(0, cur)) return;
    f32x4 acc[2][2][4][2];
#pragma unroll
    for (int a = 0; a < 2; ++a)
#pragma unroll
        for (int b = 0; b < 2; ++b)
#pragma unroll
            for (int m = 0; m < 4; ++m)
#pragma unroll
                for (int n = 0; n < 2; ++n) acc[a][b][m][n] = (f32x4){0.f, 0.f, 0.f, 0.f};
    const int f8scale = 0x7F7F7F7F; (void)f8scale;
    bf16x8 At[4][2], B0[2][2], B1[2][2]; i32x8_t At8[4], B08[2], B18[2]; (void)At; (void)B0; (void)B1; (void)At8; (void)B08; (void)B18;
    const char* cA = (const char*)g.A + (size_t)cur.pm * tstepA; const char* cB = (const char*)g.Bt + (size_t)cur.pn * tstepB;
    S.a_ready(cur);
    if constexpr (SP2) {
        PG8_STAGE(PG8_SB(0, 0), cB, voffB); PG8_STAGE(PG8_SB(0, 1), cB + hstepB, voffB); PG8_STAGE(PG8_SA(0, 0), cA, voffA); PG8_STAGE(PG8_SA(0, 1), cA + hstepA, voffA);
        if (wr == 1) PG8_BAR;
        PG8_WAIT_V(2); PG8_BAR;
        PG8_STAGE(PG8_SB(1, 0), cB + kstep, voffB); PG8_STAGE(PG8_SA(1, 0), cA + kstep, voffA); PG8_STAGE(PG8_SB(1, 1), cB + hstepB + kstep, voffB);
        PG8_WAIT_V(6); PG8_BAR;
    } else {
        PG8_STAGE(PG8_SB(0, 0), cB, voffB); PG8_STAGE(PG8_SA(0, 0), cA, voffA); PG8_STAGE(PG8_SB(0, 1), cB + hstepB, voffB); PG8_STAGE(PG8_SA(0, 1), cA + hstepA, voffA);
        if (wr == 1) PG8_BAR;
        PG8_WAIT_V(4); PG8_BAR;
        PG8_STAGE(PG8_SB(1, 0), cB + kstep, voffB); PG8_STAGE(PG8_SA(1, 0), cA + kstep, voffA); PG8_STAGE(PG8_SB(1, 1), cB + hstepB + kstep, voffB);
        PG8_WAIT_V(6); PG8_BAR;
    }
    int prep_pm = -1, prep_buf = 0; (void)prep_pm; (void)prep_buf;
    for (;;) {
        if constexpr (Epi::HAS_PREP) { if (cur.pm != prep_pm) { prep_buf ^= 1; E.prepare(cur, tid, prep_buf); prep_pm = cur.pm; } }
        const bool has_next = S.next(ui + 1, nxt);
        const char* nA = has_next ? (const char*)g.A + (size_t)nxt.pm * tstepA : cA; const char* nB = has_next ? (const char*)g.Bt + (size_t)nxt.pn * tstepB : cB;
        for (int t = 0; t < nt; t += 2) {
            const bool last = (t == nt - 2);
            const char* a1 = cA + (size_t)(t + 1) * kstep;
            const char* a2 = last ? nA : cA + (size_t)(t + 2) * kstep; const char* b2 = last ? nB : cB + (size_t)(t + 2) * kstep;
            const char* a3 = a2 + kstep; const char* b3 = b2 + kstep;
            if (last && has_next) S.a_ready(nxt);
            if constexpr (SP2) {
            PG8_LDB(B0, 0, 0); PG8_LDB(B1, 0, 1); PG8_SCHED; PG8_LDA(At, 0, 0); PG8_STAGE(PG8_SA(1, 1), a1 + hstepA, voffA);
            PG8_WAIT_V(8); PG8_WAIT_L(0); PG8_BAR; PG8_MMA(0, 0, At, B0); PG8_MMA(0, 1, At, B1); PG8_BAR; PG8_SCHED;
            PG8_LDA(At, 0, 1); PG8_STAGE(PG8_SB(0, 0), b2, voffB); PG8_STAGE(PG8_SB(0, 1), b2 + hstepB, voffB); PG8_STAGE(PG8_SA(0, 0), a2, voffA);
            PG8_WAIT_V(8); PG8_WAIT_L(0); PG8_BAR; PG8_MMA(1, 0, At, B0); PG8_MMA(1, 1, At, B1); PG8_BAR; PG8_SCHED;
            PG8_LDB(B0, 1, 0); PG8_LDB(B1, 1, 1); PG8_SCHED; PG8_LDA(At, 1, 0); PG8_STAGE(PG8_SA(0, 1), a2 + hstepA, voffA);
            PG8_WAIT_V(8); PG8_WAIT_L(0); PG8_BAR; PG8_MMA(0, 0, At, B0); PG8_MMA(0, 1, At, B1); PG8_BAR; PG8_SCHED;
            PG8_LDA(At, 1, 1); PG8_STAGE(PG8_SB(1, 0), b3, voffB); PG8_STAGE(PG8_SB(1, 1), b3 + hstepB, voffB); PG8_STAGE(PG8_SA(1, 0), a3, voffA);
            PG8_WAIT_V(8); PG8_WAIT_L(0); PG8_BAR; PG8_MMA(1, 0, At, B0); PG8_MMA(1, 1, At, B1); PG8_BAR; PG8_SCHED;
            } else {
            PG8_LDB(B0, 0, 0); PG8_SCHED; PG8_LDA(At, 0, 0); PG8_STAGE(PG8_SA(1, 1), a1 + hstepA, voffA);
            PG8_WAIT_L(8); PG8_BAR; PG8_WAIT_L(0); PG8_MMA(0, 0, At, B0); PG8_BAR; PG8_SCHED;
            PG8_LDB(B1, 0, 1); PG8_STAGE(PG8_SB(0, 0), b2, voffB);
            PG8_BAR; PG8_WAIT_L(0); PG8_MMA(0, 1, At, B1); PG8_BAR;
            PG8_LDA(At, 0, 1); PG8_STAGE(PG8_SA(0, 0), a2, voffA);
            PG8_BAR; PG8_WAIT_L(0); PG8_MMA(1, 0, At, B0); PG8_BAR; PG8_SCHED;
            PG8_STAGE(PG8_SB(0, 1), b2 + hstepB, voffB);
            PG8_WAIT_V(6); PG8_BAR; PG8_MMA(1, 1, At, B1); PG8_BAR;
            PG8_LDB(B0, 1, 0); PG8_SCHED; PG8_LDA(At, 1, 0); PG8_STAGE(PG8_SA(0, 1), a2 + hstepA, voffA);
            PG8_WAIT_L(8); PG8_BAR; PG8_WAIT_L(0); PG8_MMA(0, 0, At, B0); PG8_BAR; PG8_SCHED;
            PG8_LDB(B1, 1, 1); PG8_STAGE(PG8_SB(1, 0), b3, voffB);
            PG8_BAR; PG8_WAIT_L(0); PG8_MMA(0, 1, At, B1); PG8_BAR;
            PG8_LDA(At, 1, 1); PG8_STAGE(PG8_SA(1, 0), a3, voffA);
            PG8_BAR; PG8_WAIT_L(0); PG8_MMA(1, 0, At, B0); PG8_BAR; PG8_SCHED;
            PG8_STAGE(PG8_SB(1, 1), b3 + hstepB, voffB);
            PG8_WAIT_V(6); PG8_BAR; PG8_MMA(1, 1, At, B1); PG8_BAR;
            }
        }
        if constexpr (ALIGN_EPI) { if (wr == 0) PG8_BAR; }
        if constexpr (FP8) { asm volatile("s_nop 15\n\ts_nop 15\n\ts_nop 7" ::: "memory"); }
        if constexpr (!Epi::AFTER_DRAIN) { if constexpr (Epi::HAS_PREP) E(acc, cur, wr, wc, fr, fq, prep_buf); else E(acc, cur, wr, wc, fr, fq); S.done(cur); }
        if (!has_next) break;
#pragma unroll
        for (int a = 0; a < 2; ++a)
#pragma unroll
            for (int b = 0; b < 2; ++b)
#pragma unroll
                for (int m = 0; m < 4; ++m)
#pragma unroll
                    for (int n = 0; n < 2; ++n) acc[a][b][m][n] = (f32x4){0.f, 0.f, 0.f, 0.f};
        cur = nxt; cA = nA; cB = nB; ++ui;
        if constexpr (ALIGN_EPI) { if (wr == 1) PG8_BAR; }
    }
    PG8_WAIT_V(0);
    if constexpr (!ALIGN_EPI) { if (wr == 0) PG8_BAR; }
    PG8_BAR;
    if constexpr (Epi::AFTER_DRAIN) { E.fused(acc, cur, wr, wc, fr, fq, lds, wid, lane); S.done(cur); }
#undef PG8_SA
#undef PG8_SB
#undef PG8_STAGE
#undef PG8_LDA
#undef PG8_LDB
#undef PG8_MMA
#undef PG8_WAIT_V
#undef PG8_WAIT_L
#undef PG8_BAR
#undef PG8_SCHED
}
}
typedef GAS unsigned gu32;
#define RLX_AGENT __ATOMIC_RELAXED, __HIP_MEMORY_SCOPE_AGENT
#define XB_TMO      128
#define XB_XCNT(j)  (256  + 64 * (j))
#define XB_XSUB(j)  (1280 + 64 * (j))
#define XB_XGEN(j)  (2304 + 64 * (j))
#define XB_TOP      3328
#define XB_TOPGEN   3392
#define XCD_BAR_WORDS 3456
#define XB_SPIN_CAP (1u << 18)

__device__ __forceinline__ unsigned xb_ld(unsigned* p)              { return __hip_atomic_load(p, __ATOMIC_RELAXED, __HIP_MEMORY_SCOPE_AGENT); }
__device__ __forceinline__ unsigned xb_add(unsigned* p, unsigned v) { return __hip_atomic_fetch_add(p, v, __ATOMIC_RELAXED, __HIP_MEMORY_SCOPE_AGENT); }
__device__ __forceinline__ unsigned xb_xcc_id() { return (unsigned)__builtin_amdgcn_s_getreg((3 << 11) | 20) & 0xFu; }
#define XB_SPIN(cond, bar) do { unsigned _sp = 0; while (cond) { __builtin_amdgcn_s_sleep(1); \
    if ((++_sp & 255u) == 0u) { if (xb_ld(&(bar)[XB_TMO])) break; if (_sp > XB_SPIN_CAP) { atomicAdd(&(bar)[XB_TMO], 1u); break; } } } } while (0)

struct XcdBarrier {
    unsigned* bar; unsigned x;
    volatile LAS unsigned* st;
};

__device__ __forceinline__ XcdBarrier xcd_barrier_post(unsigned* bar, volatile LAS unsigned* st) {
    XcdBarrier b; b.bar = bar; b.x = xb_xcc_id(); b.st = st;
    if (threadIdx.x == 0) (void)xb_add(&bar[XB_XCNT(b.x)], 1u);
    return b;
}
__device__ __forceinline__ void xcd_barrier_complete(unsigned* bar, unsigned x, unsigned& nloc, unsigned& nx) {
    const unsigned G = gridDim.x * gridDim.y * gridDim.z;
    unsigned sum, cnt, mine, sp = 0u;
    for (;;) {
        sum = 0u; cnt = 0u; mine = 0u;
#pragma unroll
        for (unsigned j = 0; j < 16; ++j) { const unsigned c = xb_ld(&bar[XB_XCNT(j)]); sum += c; cnt += (c > 0u) ? 1u : 0u; mine = (j == x) ? c : mine; }
        if (sum == G) break;
        __builtin_amdgcn_s_sleep(1);
        if ((++sp & 255u) == 0u) { if (xb_ld(&bar[XB_TMO])) break; if (sp > XB_SPIN_CAP) { atomicAdd(&bar[XB_TMO], 1u); break; } }
    }
    nloc = mine > 0u ? mine : 1u; nx = cnt > 0u ? cnt : 1u;
}

__device__ __forceinline__ void xcd_barrier(const XcdBarrier& b) {
    asm volatile("s_waitcnt vmcnt(0)" ::: "memory");
    __syncthreads();
    if (threadIdx.x == 0) {
        unsigned* bar = b.bar;
        __builtin_amdgcn_s_waitcnt(0);
        unsigned nloc = b.st[0], nx = b.st[1];
        if (nloc == 0u) { xcd_barrier_complete(bar, b.x, nloc, nx); b.st[0] = nloc; b.st[1] = nx; }
        const unsigned old = xb_add(&bar[XB_XSUB(b.x)], 1u);
        const unsigned gen = old / nloc;
        if (old + 1u == (gen + 1u) * nloc) {
            __builtin_amdgcn_fence(__ATOMIC_RELEASE, "agent");
            asm volatile("s_waitcnt vmcnt(0)" ::: "memory");
            const unsigned og = xb_add(&bar[XB_TOP], 1u);
            const unsigned tg = og / nx;
            if (og + 1u == (tg + 1u) * nx) xb_add(&bar[XB_TOPGEN], 1u);
            else XB_SPIN(xb_ld(&bar[XB_TOPGEN]) == tg, bar);
            __builtin_amdgcn_fence(__ATOMIC_ACQUIRE, "agent");
            xb_add(&bar[XB_XGEN(b.x)], 1u);
            asm volatile("s_waitcnt vmcnt(0)" ::: "memory");
        } else {
            XB_SPIN(xb_ld(&bar[XB_XGEN(b.x)]) == gen, bar);
            __builtin_amdgcn_fence(__ATOMIC_ACQUIRE, "agent");
            asm volatile("s_waitcnt vmcnt(0)" ::: "memory");
        }
    }
    __syncthreads();
}
namespace pg8 {
__device__ __forceinline__ float sum16(const float* p) {
    const f32x4* sp = (const f32x4*)p; f32x4 a = sp[0] + sp[1]; const f32x4 b = sp[2] + sp[3]; a = a + b; return (a[0] + a[1]) + (a[2] + a[3]);
}
__device__ __forceinline__ float row_rs(const float* statx, int row) { return __builtin_amdgcn_rsqf(sum16(statx + (size_t)row * 16) * (1.0f / 1024.0f) + EPS); }

constexpr int RS_TAB_OFF = 131072 + 1024;
__device__ __forceinline__ void rs_prepare(PG8_LAS float* tab, const float* rstat, int pitch, int slot0, int n, float invdim, int row0, int tid) {
    const int r = tid >> 1, h = tid & 1; const float* rp = rstat + (size_t)(row0 + r) * pitch + slot0; float s = 0.f;
    for (int c = h; 4 * c < n; c += 2) { const f32x4 t = *(const f32x4*)(rp + 4 * c); s += (t[0] + t[1]) + (t[2] + t[3]); }
    s += __shfl_xor(s, 1);
    if (h == 0) tab[r] = __builtin_amdgcn_rsqf(s * invdim + EPS);
}
template <bool F8> struct EpiSwiGLU {
    static constexpr bool PERM = true, AFTER_DRAIN = false, HAS_PREP = true;
    unsigned char* O; const float* statx; PG8_LAS float* tab; float ascale;
    __device__ __forceinline__ void prepare(const Unit& u, int tid, int buf) const { rs_prepare(tab + 256 * buf, statx, 16, 0, 16, 1.0f / 1024.0f, u.pm * BM, tid); }
    __device__ __forceinline__ void operator()(const f32x4 (&acc)[2][2][4][2], const Unit& u, int wr, int wc, int fr, int fq, int buf) const {
        const int row0 = u.pm * BM + wr * 64 + fr, col0 = u.pn * HALF + wc * 32 + 8 * fq;
        const PG8_LAS float* tp = tab + 256 * buf + wr * 64 + fr; float rsv[2][4];
#pragma unroll
        for (int ai = 0; ai < 2; ++ai)
#pragma unroll
            for (int m = 0; m < 4; ++m) rsv[ai][m] = tp[ai * HALF + m * 16] * ascale;
#pragma unroll
        for (int ai = 0; ai < 2; ++ai)
#pragma unroll
            for (int m = 0; m < 4; ++m) {
                int row = row0 + ai * HALF + m * 16; asm volatile("" : "+v"(row)); const float rs = rsv[ai][m];
                float o[8];
#pragma unroll
                for (int n = 0; n < 2; ++n)
#pragma unroll
                    for (int e = 0; e < 4; ++e) { const float g = acc[ai][0][m][n][e] * rs, uu = acc[ai][1][m][n][e] * rs;
                        o[4 * n + e] = g * uu * __builtin_amdgcn_rcpf(1.0f + __builtin_amdgcn_exp2f(-LOG2E * g)); }
                if constexpr (F8) {
#pragma unroll
                for (int e = 0; e < 8; ++e) o[e] = __builtin_fminf(__builtin_fmaxf(o[e] * ACT_F8_SCALE, -448.0f), 448.0f);
                int w0 = 0, w1 = 0;
                w0 = __builtin_amdgcn_cvt_pk_fp8_f32(o[0], o[1], w0, false); w0 = __builtin_amdgcn_cvt_pk_fp8_f32(o[2], o[3], w0, true);
                w1 = __builtin_amdgcn_cvt_pk_fp8_f32(o[4], o[5], w1, false); w1 = __builtin_amdgcn_cvt_pk_fp8_f32(o[6], o[7], w1, true);
                *(u32x2*)(O + (size_t)row * FF + col0) = (u32x2){(unsigned)w0, (unsigned)w1};
                } else {
                    u32x4 w; w.x = cvt_pk_bf16(o[0], o[1]); w.y = cvt_pk_bf16(o[2], o[3]); w.z = cvt_pk_bf16(o[4], o[5]); w.w = cvt_pk_bf16(o[6], o[7]);
                    *(u32x4*)((bf16_t*)O + (size_t)row * FF + col0) = w;
                }
            }
    }
};
struct EpiResid {
    static constexpr bool PERM = true, AFTER_DRAIN = false, HAS_PREP = false;
    bf16_t* xb; float* statx; float alpha; unsigned char* xb8 = nullptr;
    __device__ __forceinline__ void operator()(const f32x4 (&acc)[2][2][4][2], const Unit& u, int wr, int wc, int fr_, int fq_) const {
        int fr = fr_, fq = fq_; asm volatile("" : "+v"(fr), "+v"(fq));
        const int row0 = u.pm * BM + wr * 64 + fr, col0 = u.pn * BM + wc * 32 + 8 * fq;
        u32x4 xv[8][2];
#pragma unroll
        for (int idx = 0; idx < 8; ++idx) { const int row = row0 + (idx >> 2) * HALF + (idx & 3) * 16; const size_t off = (size_t)row * DM + col0;
            xv[idx][0] = *(const u32x4*)(xb + off); xv[idx][1] = *(const u32x4*)(xb + off + HALF); }
#pragma unroll
        for (int idx = 0; idx < 8; ++idx) {
            const int ai = idx >> 2, m = idx & 3;
            int row = row0 + ai * HALF + m * 16; asm volatile("" : "+v"(row)); const size_t off = (size_t)row * DM + col0; float ss = 0.f;
#pragma unroll
            for (int bj = 0; bj < 2; ++bj) {
                const u32x4 b = xv[idx][bj];
                float v[8];
#pragma unroll
                for (int e = 0; e < 4; ++e) { v[2 * e] = __builtin_bit_cast(float, b[e] << 16) + acc[ai][bj][m][e >> 1][2 * (e & 1)] * alpha;
                                              v[2 * e + 1] = __builtin_bit_cast(float, b[e] & 0xFFFF0000u) + acc[ai][bj][m][e >> 1][2 * (e & 1) + 1] * alpha; }
                u32x4 w; w.x = cvt_pk_bf16(v[0], v[1]); w.y = cvt_pk_bf16(v[2], v[3]); w.z = cvt_pk_bf16(v[4], v[5]); w.w = cvt_pk_bf16(v[6], v[7]);
                *(u32x4*)(xb + off + bj * HALF) = w;
                if (xb8) { float q[8];
#pragma unroll
                    for (int e = 0; e < 8; ++e) q[e] = __builtin_fminf(__builtin_fmaxf(v[e] * X_F8_SCALE, -448.0f), 448.0f);
                    int w0 = 0, w1 = 0; w0 = __builtin_amdgcn_cvt_pk_fp8_f32(q[0], q[1], w0, false); w0 = __builtin_amdgcn_cvt_pk_fp8_f32(q[2], q[3], w0, true);
                    w1 = __builtin_amdgcn_cvt_pk_fp8_f32(q[4], q[5], w1, false); w1 = __builtin_amdgcn_cvt_pk_fp8_f32(q[6], q[7], w1, true);
                    *(u32x2*)(xb8 + off + bj * HALF) = (u32x2){(unsigned)w0, (unsigned)w1}; }
#pragma unroll
                for (int e = 0; e < 8; ++e) ss += v[e] * v[e];
            }
            ss += __shfl_xor(ss, 16); ss += __shfl_xor(ss, 32);
            if (fq == 0) statx[(size_t)row * 16 + u.pn * 4 + wc] = ss;
            asm volatile("" ::: "memory");
        }
    }
};
template <bool STATS> struct EpiScatter {
    static constexpr bool PERM = true, AFTER_DRAIN = false, HAS_PREP = true;
    const Desc* tab; unsigned char* ws; const float* rstat; int rs_pitch, rs_slot0, rs_n; float rs_invdim; float* statc; PG8_LAS float* rtab; int pn0 = 0; float ascale = 1.0f;
    __device__ __forceinline__ void prepare(const Unit& u, int tid, int buf) const { rs_prepare(rtab + 256 * buf, rstat, rs_pitch, rs_slot0, rs_n, rs_invdim, u.pm * BM, tid); }
    __device__ __forceinline__ float scale_of(int id) const { return id == 0 ? 1.0f : (id == 1 ? C2_64 : C2_96); }
    __device__ __forceinline__ void store8(int buf, int col, int row, bool asf32, const float (&v)[8]) const {
        if (buf < 0) return;
        unsigned char* p = ws + BUF_OFF[buf];
        const size_t idx = (size_t)row * BUF_PITCH[buf] + col;
        if (asf32) { float* q = (float*)p + idx; *(f32x4*)q = (f32x4){v[0], v[1], v[2], v[3]}; *(f32x4*)(q + 4) = (f32x4){v[4], v[5], v[6], v[7]}; }
        else { u32x4 w; w.x = cvt_pk_bf16(v[0], v[1]); w.y = cvt_pk_bf16(v[2], v[3]); w.z = cvt_pk_bf16(v[4], v[5]); w.w = cvt_pk_bf16(v[6], v[7]); *(u32x4*)((bf16_t*)p + idx) = w; }
    }
    __device__ __forceinline__ void operator()(const f32x4 (&acc)[2][2][4][2], const Unit& u, int wr, int wc, int fr, int fq, int buf) const {
        const PG8_LAS float* tp = rtab + 256 * buf + wr * 64 + fr; float rsv[2][4];
#pragma unroll
        for (int ai = 0; ai < 2; ++ai)
#pragma unroll
            for (int m = 0; m < 4; ++m) rsv[ai][m] = tp[ai * HALF + m * 16] * ascale;
        const Desc d = tab[(u.pn + pn0) * 8 + 2 * wc + (fq >> 1)];
        const int sub = (fq & 1) * 8;
        const float sc0 = scale_of(d.scale0), sc1 = scale_of(d.scale1);
        const int row0 = u.pm * BM + wr * 64 + fr;
        const bool v0 = d.buf0 >= 0, v1 = d.buf1 >= 0;
        unsigned char* const p0 = ws + (v0 ? BUF_OFF[d.buf0] : 0ull) + (size_t)(d.col0 + sub) * 2;
        unsigned char* const p1 = ws + (v1 ? BUF_OFF[d.buf1] : 0ull) + (size_t)(d.col1 + sub) * 2;
        const size_t pb0 = (size_t)(v0 ? BUF_PITCH[d.buf0] : 0) * 2, pb1 = (size_t)(v1 ? BUF_PITCH[d.buf1] : 0) * 2;
        if (STATS) {
            const int st0 = __builtin_amdgcn_readfirstlane((int)d.stat0), st1 = __builtin_amdgcn_readfirstlane((int)d.stat1);
            if (st0 >= 0 || st1 >= 0) {
#pragma unroll
                for (int ai = 0; ai < 2; ++ai)
#pragma unroll
                    for (int m = 0; m < 4; ++m) {
                        int row = row0 + ai * HALF + m * 16; asm volatile("" : "+v"(row));
                        const float rs = rsv[ai][m]; float s0 = 0.f, s1 = 0.f;
#pragma unroll
                        for (int n = 0; n < 2; ++n)
#pragma unroll
                            for (int e = 0; e < 4; ++e) { const float x = acc[ai][0][m][n][e] * rs, y = acc[ai][1][m][n][e] * rs; s0 += x * x; s1 += y * y; }
                        s0 += __shfl_xor(s0, 16); s0 += __shfl_xor(s0, 32); s1 += __shfl_xor(s1, 16); s1 += __shfl_xor(s1, 32);
                        if (fq == 0 && st0 >= 0) statc[(size_t)row * 32 + st0 + wc] = s0;
                        if (fq == 0 && st1 >= 0) statc[(size_t)row * 32 + st1 + wc] = s1;
                        asm volatile("" ::: "memory");
                    }
            }
        }
        const int ropeid = d.rope; const int jsub = d.j0 + sub;
        f32x4 csn[4] = {};
#define EPI_ROPE_LOAD(dst, rw) do { const int pos_ = (rw) & (SEQ - 1); \
            const float* tp_ = (ropeid == 1) ? (const float*)(ws + WS_TAB64) + ((size_t)pos_ * 32 + jsub) * 2 : (const float*)(ws + WS_TAB32) + ((size_t)pos_ * 16 + jsub) * 2; \
            _Pragma("unroll") for (int i_ = 0; i_ < 4; ++i_) dst[i_] = *(const f32x4*)(tp_ + 4 * i_); } while (0)
        if (ropeid) { int r0_ = row0; asm volatile("" : "+v"(r0_)); EPI_ROPE_LOAD(csn, r0_); }
#pragma unroll
        for (int idx = 0; idx < 8; ++idx) {
                const int ai = idx >> 2, m = idx & 3;
                int row = row0 + ai * HALF + m * 16; asm volatile("" : "+v"(row));
                const float rs = rsv[ai][m];
                float a[8], b[8];
#pragma unroll
                for (int n = 0; n < 2; ++n)
#pragma unroll
                    for (int e = 0; e < 4; ++e) { a[4 * n + e] = acc[ai][0][m][n][e] * rs; b[4 * n + e] = acc[ai][1][m][n][e] * rs; }
                if (ropeid) {
                    f32x4 cs[4];
#pragma unroll
                    for (int i = 0; i < 4; ++i) cs[i] = csn[i];
                    if (idx < 7) { int rn_ = row0 + ((idx + 1) >> 2) * HALF + ((idx + 1) & 3) * 16; asm volatile("" : "+v"(rn_)); EPI_ROPE_LOAD(csn, rn_); }
#pragma unroll
                    for (int e = 0; e < 8; ++e) { const float c = cs[e >> 1][2 * (e & 1)], s = cs[e >> 1][2 * (e & 1) + 1]; const float x1 = a[e], x2 = b[e]; a[e] = x1 * c - x2 * s; b[e] = x1 * s + x2 * c; }
                }
#pragma unroll
                for (int e = 0; e < 8; ++e) { a[e] *= sc0; b[e] *= sc1; }
                if (v0) { u32x4 w; w.x = cvt_pk_bf16(a[0], a[1]); w.y = cvt_pk_bf16(a[2], a[3]); w.z = cvt_pk_bf16(a[4], a[5]); w.w = cvt_pk_bf16(a[6], a[7]); *(u32x4*)(p0 + (size_t)row * pb0) = w; }
                if (v1) { u32x4 w; w.x = cvt_pk_bf16(b[0], b[1]); w.y = cvt_pk_bf16(b[2], b[3]); w.z = cvt_pk_bf16(b[4], b[5]); w.w = cvt_pk_bf16(b[6], b[7]); *(u32x4*)(p1 + (size_t)row * pb1) = w; }
                asm volatile("" ::: "memory");
        }
#undef EPI_ROPE_LOAD
    }
};
}
constexpr int RING_OFF = 0, RING_BYTES = 131072;
constexpr int LDSCTL_OFF = RING_BYTES, MISC_OFF = LDSCTL_OFF + 320;
constexpr int LDS_BYTES = 147456;
#define LDS_WAIT() asm volatile("s_waitcnt lgkmcnt(0)" ::: "memory")
#define VM_WAIT() asm volatile("s_waitcnt vmcnt(0)" ::: "memory")
__device__ __forceinline__ unsigned f2bf(float f) { unsigned u = __builtin_bit_cast(unsigned, f); return (u + 0x7fffu + ((u >> 16) & 1u)) >> 16; }
__device__ __forceinline__ unsigned pk2(float lo, float hi) { return f2bf(lo) | (f2bf(hi) << 16); }
__device__ __forceinline__ float wave_sum(float v) {
#pragma unroll
    for (int o = 1; o < 64; o <<= 1) v += __shfl_xor(v, o);
    return v;
}

template <class T> __device__ __forceinline__ T* opaque_global(T* p) { GAS T* g = (GAS T*)p; asm volatile("" : "+s"(g)); return (T*)g; }
struct Frame {
    LAS unsigned char* lds;
    volatile LAS unsigned* MISC;
    gu32* ctl;
    unsigned char* ws;
    int wave, vcu, G;
};

template <int MODE>
__device__ __forceinline__ void conv_item(const float* W0, const float* W1, const short* map, const float* gain, int K, int Nsrc, bf16_t* WT, LAS float* scr, int item, int nblk, int lane) {
    const int kb = item / nblk, nb = item % nblk, k0 = 64 * kb, n0 = 32 * nb;
    const int n = n0 + (lane & 31);
    const float* W = W0; int col = n;
    if (MODE == 1) { col = (n >> 8) * 128 + (n & 127); W = ((n >> 7) & 1) ? W1 : W0; }
    if (MODE == 2) col = map[n];
    float wv[32];
    const float* wp = W + (size_t)(k0 + (lane >> 5)) * Nsrc + (col >= 0 ? col : 0);
    const int c = lane & 7;
    f32x4 g0 = {1.f, 1.f, 1.f, 1.f}, g1 = {1.f, 1.f, 1.f, 1.f};
    if (gain) { const f32x4* gp = (const f32x4*)(gain + k0 + 8 * c); g0 = gp[0]; g1 = gp[1]; }
#pragma unroll
    for (int i = 0; i < 32; ++i) wv[i] = wp[(size_t)(2 * i) * Nsrc];
#pragma unroll
    for (int i = 0; i < 32; ++i) { const int kk = 2 * i + (lane >> 5); const float v = (col >= 0) ? wv[i] : 0.f; scr[kk * 33 + (lane & 31)] = v; }
    LDS_WAIT(); asm volatile("" ::: "memory");
#pragma unroll
    for (int j = 0; j < 4; ++j) { const int nn = (lane >> 3) + 8 * j; const LAS float* s = scr + (8 * c) * 33 + nn;
        u32x4 o; o.x = pk2(s[0 * 33] * g0[0], s[1 * 33] * g0[1]); o.y = pk2(s[2 * 33] * g0[2], s[3 * 33] * g0[3]); o.z = pk2(s[4 * 33] * g1[0], s[5 * 33] * g1[1]); o.w = pk2(s[6 * 33] * g1[2], s[7 * 33] * g1[3]);
        *(GAS u32x4*)(WT + (size_t)(n0 + nn) * K + k0 + 8 * c) = o; }
    LDS_WAIT(); asm volatile("" ::: "memory");
}
template <int MODE = 0>
__device__ __forceinline__ void conv_item_f8(const float* W0, int K, int Nsrc, unsigned char* WT8, LAS float* scr, int item, int nblk, int lane, float scale, const float* W1 = nullptr, const float* gain = nullptr, const short* map = nullptr) {
    const int kb = item / nblk, nb = item % nblk, k0 = 64 * kb, n0 = 32 * nb;
    const int n = n0 + (lane & 31);
    const float* W = W0; int col = n;
    if (MODE == 1) { col = (n >> 8) * 128 + (n & 127); W = ((n >> 7) & 1) ? W1 : W0; }
    if (MODE == 2) col = map[n];
    float wv[32];
    const float* wp = W + (size_t)(k0 + (lane >> 5)) * Nsrc + (col >= 0 ? col : 0);
    const int c = lane & 7;
    f32x4 g0 = {1.f, 1.f, 1.f, 1.f}, g1 = {1.f, 1.f, 1.f, 1.f};
    if (gain) { const f32x4* gp = (const f32x4*)(gain + k0 + 8 * c); g0 = gp[0]; g1 = gp[1]; }
#pragma unroll
    for (int i = 0; i < 32; ++i) wv[i] = wp[(size_t)(2 * i) * Nsrc];
#pragma unroll
    for (int i = 0; i < 32; ++i) { const int kk = 2 * i + (lane >> 5); scr[kk * 33 + (lane & 31)] = (col >= 0) ? wv[i] : 0.f; }
    LDS_WAIT(); asm volatile("" ::: "memory");
#pragma unroll
    for (int j = 0; j < 4; ++j) { const int nn = (lane >> 3) + 8 * j; const LAS float* s = scr + (8 * c) * 33 + nn; float v[8];
#pragma unroll
        for (int e = 0; e < 8; ++e) v[e] = __builtin_fminf(__builtin_fmaxf(s[e * 33] * (e < 4 ? g0[e & 3] : g1[e & 3]) * scale, -448.0f), 448.0f);
        int w0 = 0, w1 = 0;
        w0 = __builtin_amdgcn_cvt_pk_fp8_f32(v[0], v[1], w0, false); w0 = __builtin_amdgcn_cvt_pk_fp8_f32(v[2], v[3], w0, true);
        w1 = __builtin_amdgcn_cvt_pk_fp8_f32(v[4], v[5], w1, false); w1 = __builtin_amdgcn_cvt_pk_fp8_f32(v[6], v[7], w1, true);
        *(GAS u32x2*)(WT8 + (size_t)(n0 + nn) * K + k0 + 8 * c) = (u32x2){(unsigned)w0, (unsigned)w1}; }
    LDS_WAIT(); asm volatile("" ::: "memory");
}
struct In { const float* p[18]; };
__device__ __forceinline__ void p0_prologue(Frame& F, const In& in) {
    int tid_ = threadIdx.x; asm volatile("" : "+v"(tid_)); const int tid = tid_, lane = tid & 63;
    LAS float* scr = (LAS float*)(F.lds + RING_OFF + F.wave * 16384);
    const int gw = F.vcu * NWAVES + F.wave, NGW = F.G * NWAVES;
    constexpr int I_GU = 16 * 176, I_D = 44 * 32, I_IN = 16 * (NIN / 32), I_IW = 16, I_UQ = 6 * 16, I_UKV = 4 * 24, I_O = 16 * 32;
    constexpr int PER_LAYER = 2 * (I_GU + I_D) + I_IN + I_IW + I_UQ + I_UKV + I_O;
    for (int it = gw; it < DEPTH * PER_LAYER; it += NGW) {
        const int l = it / PER_LAYER; int r = it % PER_LAYER;
        unsigned char* wl = F.ws + WS_W + (size_t)l * W_LAYER;
        if (r < I_GU) { if (gu_is_f8(l, 0)) conv_item_f8<1>(in.p[2] + (size_t)l * DM * FF, DM, FF, wl + W_GU1, scr, r, 176, lane, WGU_F8_SCALE, in.p[3] + (size_t)l * DM * FF, in.p[1] + l * DM);
                        else conv_item<1>(in.p[2] + (size_t)l * DM * FF, in.p[3] + (size_t)l * DM * FF, nullptr, in.p[1] + l * DM, DM, FF, (bf16_t*)(wl + W_GU1), scr, r, 176, lane); continue; } r -= I_GU;
        if (r < I_GU) { if (gu_is_f8(l, 1)) conv_item_f8<1>(in.p[14] + (size_t)l * DM * FF, DM, FF, wl + W_GU2, scr, r, 176, lane, WGU_F8_SCALE, in.p[15] + (size_t)l * DM * FF, in.p[13] + l * DM);
                        else conv_item<1>(in.p[14] + (size_t)l * DM * FF, in.p[15] + (size_t)l * DM * FF, nullptr, in.p[13] + l * DM, DM, FF, (bf16_t*)(wl + W_GU2), scr, r, 176, lane); continue; } r -= I_GU;
        if (r < I_D) { if (d_is_f8(l, 0)) conv_item_f8(in.p[4] + (size_t)l * FF * DM, FF, DM, wl + W_D1, scr, r, 32, lane, WD_F8_SCALE);
                       else conv_item<0>(in.p[4] + (size_t)l * FF * DM, nullptr, nullptr, nullptr, FF, DM, (bf16_t*)(wl + W_D1), scr, r, 32, lane); continue; } r -= I_D;
        if (r < I_D) { if (d_is_f8(l, 1)) conv_item_f8(in.p[16] + (size_t)l * FF * DM, FF, DM, wl + W_D2, scr, r, 32, lane, WD_F8_SCALE);
                       else conv_item<0>(in.p[16] + (size_t)l * FF * DM, nullptr, nullptr, nullptr, FF, DM, (bf16_t*)(wl + W_D2), scr, r, 32, lane); continue; } r -= I_D;
        if (r < I_IN) { if (win_is_f8(l) && (r % (NIN / 32)) < WIN_F8_TILES * 8) conv_item_f8<2>(in.p[6] + (size_t)l * DM * 3080, DM, 3080, wl + W_IN, scr, r, NIN / 32, lane, WIN_F8_SCALE, nullptr, in.p[5] + l * DM, WIN_SRC);
                        else conv_item<2>(in.p[6] + (size_t)l * DM * 3080, nullptr, WIN_SRC, in.p[5] + l * DM, DM, 3080, (bf16_t*)(wl + W_IN), scr, r, NIN / 32, lane); continue; } r -= I_IN;
        if (r < I_IW) { conv_item<2>(in.p[6] + (size_t)l * DM * 3080, nullptr, WIW_SRC, in.p[5] + l * DM, DM, 3080, (bf16_t*)(wl + W_IW), scr, r, 1, lane); continue; } r -= I_IW;
        if (r < I_UQ) { conv_item<2>(in.p[10] + (size_t)l * 384 * 480, nullptr, WUQ_SRC, in.p[8] + l * 384, 384, 480, (bf16_t*)(wl + W_UQ), scr, r, 16, lane); continue; } r -= I_UQ;
        if (r < I_UKV) { conv_item<2>(in.p[11] + (size_t)l * 256 * 640, nullptr, WUKV_SRC, in.p[9] + l * 256, 256, 640, (bf16_t*)(wl + W_UKV), scr, r, 24, lane); continue; } r -= I_UKV;
        if (wo_is_f8(l)) conv_item_f8(in.p[12] + (size_t)l * DM * DM, DM, DM, wl + W_OUT, scr, r, 32, lane, WO_F8_SCALE);
        else conv_item<0>(in.p[12] + (size_t)l * DM * DM, nullptr, nullptr, nullptr, DM, DM, (bf16_t*)(wl + W_OUT), scr, r, 32, lane);
    }
    { const int gt = F.vcu * (NWAVES * 64) + tid, NGT = F.G * NWAVES * 64;
      for (int e = gt; e < SEQ * 48; e += NGT) {
          int pos, j; double inv; float* dst;
          if (e < SEQ * 32) { pos = e >> 5; j = e & 31; inv = INV64[j]; dst = (float*)(F.ws + WS_TAB64) + (size_t)e * 2; }
          else { const int e2 = e - SEQ * 32; pos = e2 >> 4; j = e2 & 15; inv = INV32[j]; dst = (float*)(F.ws + WS_TAB32) + (size_t)e2 * 2; }
          double rv = (double)pos * inv * 0.15915494309189535; rv -= __builtin_rint(rv);
          const float rf = (float)rv;
          *(f32x2*)dst = (f32x2){__builtin_amdgcn_cosf(rf), __builtin_amdgcn_sinf(rf)};
      } }
    const float* x = in.p[0]; bf16_t* xb = (bf16_t*)(F.ws + WS_XB); float* statx = (float*)(F.ws + WS_STATX);
    for (int m0 = 2 * gw; m0 < M; m0 += 2 * NGW) {
        f32x4 v[2][4];
#pragma unroll
        for (int r = 0; r < 2; ++r) { const GAS f32x4* xr = (const GAS f32x4*)(x + (size_t)(m0 + r) * DM) + lane;
#pragma unroll
            for (int j = 0; j < 4; ++j) v[r][j] = xr[64 * j]; }
#pragma unroll
        for (int r = 0; r < 2; ++r) { GAS unsigned long long* o8 = (GAS unsigned long long*)(xb + (size_t)(m0 + r) * DM) + lane; float s = 0.f;
#pragma unroll
            for (int j = 0; j < 4; ++j) { const f32x4 t = v[r][j]; s += (t.x * t.x + t.y * t.y) + (t.z * t.z + t.w * t.w);
                o8[64 * j] = (unsigned long long)pk2(t.x, t.y) | ((unsigned long long)pk2(t.z, t.w) << 32); }
            s = wave_sum(s);
            if (lane < 16) statx[(size_t)(m0 + r) * 16 + lane] = (lane == 0) ? s : 0.f; }
    }
}
__device__ __forceinline__ void final_norm(Frame& F, float* out, const float* g) {
    int tid_ = threadIdx.x; asm volatile("" : "+v"(tid_)); const int lane = tid_ & 63;
    const int gw = F.vcu * NWAVES + F.wave, NGW = F.G * NWAVES; const float* statx = (const float*)(F.ws + WS_STATX); const bf16_t* xb = (const bf16_t*)(F.ws + WS_XB);
    f32x4 gv[4];
#pragma unroll
    for (int j = 0; j < 4; ++j) gv[j] = *((const f32x4*)g + lane + 64 * j);
    for (int m = gw; m < M; m += 2 * NGW) {
        float rs[2]; u32x2 b[2][4];
#pragma unroll
        for (int r = 0; r < 2; ++r) { const int mr = (m + r * NGW < M) ? m + r * NGW : m; rs[r] = pg8::row_rs(statx, mr);
            const GAS u32x2* xr = (const GAS u32x2*)(xb + (size_t)mr * DM) + lane;
#pragma unroll
            for (int j = 0; j < 4; ++j) b[r][j] = xr[64 * j]; }
#pragma unroll
        for (int r = 0; r < 2; ++r) { if (m + r * NGW >= M) break; GAS f32x4* orow = (GAS f32x4*)(out + (size_t)(m + r * NGW) * DM) + lane;
#pragma unroll
            for (int j = 0; j < 4; ++j) { const u32x2 bb = b[r][j];
                f32x4 v = {__builtin_bit_cast(float, bb.x << 16), __builtin_bit_cast(float, bb.x & 0xFFFF0000u), __builtin_bit_cast(float, bb.y << 16), __builtin_bit_cast(float, bb.y & 0xFFFF0000u)};
                orow[64 * j] = v * rs[r] * gv[j]; } }
    }
}
namespace att {
constexpr int KSLOT = 12288, VSLOT = 8192;
constexpr int NSLOT = 4, TSLOT = KSLOT + VSLOT, L_K = 0, L_V = KSLOT, L_BIAS = NSLOT * TSLOT, L_END = L_BIAS + 1024;
constexpr float RESC_THR = 8.0f;
constexpr float NEGB = -1e30f;
__device__ __forceinline__ s16x4 vtr(const LAS unsigned char* p) { return __builtin_bit_cast(s16x4, __builtin_amdgcn_ds_read_tr16_b64_v4i16((LAS s16x4*)p)); }
__device__ __forceinline__ void swap32(float& x, float& y) { asm volatile("s_nop 1\n\tv_permlane32_swap_b32 %0, %1\n\ts_nop 0" : "+v"(x), "+v"(y)); }
__device__ __forceinline__ void swap32u(unsigned& x, unsigned& y) { asm volatile("s_nop 1\n\tv_permlane32_swap_b32 %0, %1\n\ts_nop 0" : "+v"(x), "+v"(y)); }
__device__ __forceinline__ void swap16(float& x, float& y) { asm volatile("s_nop 1\n\tv_permlane16_swap_b32 %0, %1\n\ts_nop 0" : "+v"(x), "+v"(y)); }
__device__ __forceinline__ float rows_max(float m) { float x = m + 0.f, y = m + 0.f; swap16(x, y); float t = __builtin_fmaxf(x, y) + 0.f; float x2 = t, y2 = t; swap32(x2, y2); return __builtin_fmaxf(x2, y2); }
__device__ __forceinline__ float rows_sum(float m) { float x = m + 0.f, y = m + 0.f; swap16(x, y); float t = x + y; float x2 = t, y2 = t; swap32(x2, y2); return x2 + y2; }
__device__ __forceinline__ float cnd(float neg, float s, unsigned long long mask) { return __builtin_amdgcn_inverse_ballot_w64(mask) ? s : neg; }

__device__ __forceinline__ void glds16s(const void* sbase, unsigned voff, unsigned lds_dst) { unsigned keep;
    asm volatile("s_mov_b32 %0, m0\n\ts_mov_b32 m0, %3\n\ts_nop 0\n\tglobal_load_lds_dwordx4 %1, %2\n\ts_mov_b32 m0, %0" : "=&s"(keep) : "v"(voff), "s"(sbase), "s"(lds_dst) : "memory"); }
template <int MODE>
__device__ __forceinline__ void attn_unit(Frame& F, int b, int h, int qb, const float* bias  , const unsigned* bmbase  , bool do_store = true, unsigned char* o8 = nullptr  ) {
    constexpr int DK = (MODE == 2) ? 96 : 64, NS = DK / 32;
    int tid_ = threadIdx.x; asm volatile("" : "+v"(tid_));
    const int tid = tid_, lane = tid & 63, l16 = lane & 15, rg = lane >> 4, wid = __builtin_amdgcn_readfirstlane(tid >> 6);
    const int Rrg = 8 * (rg & 1) + 4 * (rg >> 1);
    LAS unsigned char* const L = F.lds;
    unsigned char* const ws = opaque_global(F.ws);
    const int q0 = qb * 256;
    const size_t rowb = (size_t)b * SEQ;
    bf16_t* const QO = (bf16_t*)(ws + WS_QO);
    const int qcol = (MODE == 0) ? 64 * h : (MODE == 1) ? 384 + 64 * h : 704 + 64 * h;
    const bf16_t* Kb; const bf16_t* Vb; int kp, vp;
    if (MODE == 0) { Kb = (const bf16_t*)(ws + WS_KA) + 64 * h; Vb = (const bf16_t*)(ws + WS_VA) + 64 * h; kp = 384; vp = 384; }
    else if (MODE == 1) { Kb = (const bf16_t*)(ws + WS_KB) + 64 * h; Vb = (const bf16_t*)(ws + WS_VB) + 64 * h; kp = 320; vp = 320; }
    else { Kb = (const bf16_t*)(ws + WS_KN) + 64 * h; Vb = (const bf16_t*)(ws + WS_VC) + 64 * h; kp = 320; vp = 320; }
    const bf16_t* const KRb = (const bf16_t*)(ws + WS_KR);
    const int cw = 4 * qb + (wid >> 1);
    const int t_hi = 4 * qb + 3;
    const int t_lo = (MODE == 0) ? ((4 * qb - 8) > 0 ? (4 * qb - 8) : 0) : 0;
    bf16x8 qr[2][NS];
#pragma unroll
    for (int qb2 = 0; qb2 < 2; ++qb2) { const bf16_t* qrow = QO + (rowb + q0 + wid * 32 + 16 * qb2 + l16) * QO_PITCH;
#pragma unroll
      for (int s = 0; s < NS; ++s) { const bf16_t* p = (MODE == 2 && s == 2) ? qrow + 1024 + 32 * h + 8 * rg : qrow + qcol + 32 * s + 8 * rg; qr[qb2][s] = *(const bf16x8*)p; } }
    if (MODE == 0) { if (tid < 192) ((LAS float*)(L + L_BIAS))[tid] = bias[h * 192 + tid] * LOG2E; }
    const bf16_t* const ksb = Kb + rowb * kp; const bf16_t* const k2sb = KRb + rowb * 32; const bf16_t* const vsb = Vb + rowb * vp;
    const unsigned kvo = (unsigned)((lane * kp + wid * 8) * 2), k2vo = (unsigned)((lane * 32 + (wid & 3) * 8) * 2),
                   vvo = (unsigned)(((16 * (wid & 3) + (lane >> 2)) * vp + (wid >> 2) * 32 + (lane & 3) * 8) * 2);
    const bool w2 = (MODE == 2) && (wid < 4);
    const unsigned lds0 = (unsigned)(size_t)L;
#define DMA_T(t, s) do { glds16s(ksb + (size_t)(t) * 64 * kp, kvo, (unsigned)__builtin_amdgcn_readfirstlane(lds0 + L_K + (s) * TSLOT + wid * 1024)); \
        glds16s(vsb + (size_t)(t) * 64 * vp, vvo, (unsigned)__builtin_amdgcn_readfirstlane(lds0 + L_V + (s) * TSLOT + wid * 1024)); \
        if (w2) glds16s(k2sb + (size_t)(t) * 64 * 32, k2vo, (unsigned)__builtin_amdgcn_readfirstlane(lds0 + L_K + (s) * TSLOT + (8 + wid) * 1024)); } while (0)
#define WAIT_BAR(more) do { if (more) { if (w2) asm volatile("s_waitcnt vmcnt(3) lgkmcnt(0)" ::: "memory"); else asm volatile("s_waitcnt vmcnt(2) lgkmcnt(0)" ::: "memory"); } \
        else asm volatile("s_waitcnt vmcnt(0) lgkmcnt(0)" ::: "memory"); __builtin_amdgcn_s_barrier(); asm volatile("" ::: "memory"); } while (0)
#define VIS(t) ((MODE == 0) ? ((t) <= cw && (t) + 8 >= cw) : ((t) <= cw))
    const LAS unsigned char* const kfb = L + L_K + rg * 1024 + (8 * ((l16 >> 2) & 1) + 4 * (l16 >> 3) + (l16 & 3)) * 16;
    const LAS unsigned char* const vfb = L + L_V + (Rrg + (l16 >> 2)) * 64 + (l16 & 3) * 8;
#define KLOAD(s) do { const LAS unsigned char* kf_ = kfb + (s) * TSLOT; \
        _Pragma("unroll") for (int kb = 0; kb < 4; ++kb) _Pragma("unroll") for (int ss = 0; ss < NS; ++ss) kfr[kb][ss] = *(const LAS bf16x8*)(kf_ + ss * 4096 + kb * 256); } while (0)
#define QKS(SN, ss) do { _Pragma("unroll") for (int kb = 0; kb < 4; ++kb) _Pragma("unroll") for (int qb2 = 0; qb2 < 2; ++qb2) \
        SN[kb][qb2] = __builtin_amdgcn_mfma_f32_16x16x32_bf16(kfr[kb][ss], qr[qb2][ss], (ss) == 0 ? negm[qb2] : SN[kb][qb2], 0, 0, 0); } while (0)
#define VREAD(V, ks) do { _Pragma("unroll") for (int dvb = 0; dvb < 4; ++dvb) { const LAS unsigned char* p_ = vf_ + (dvb >> 1) * 4096 + (dvb & 1) * 32 + (ks) * 2048; \
        const s16x4 lo_ = vtr(p_), hi_ = vtr(p_ + 1024); V[dvb] = (bf16x8){lo_[0], lo_[1], lo_[2], lo_[3], hi_[0], hi_[1], hi_[2], hi_[3]}; } } while (0)
    f32x4 O[4][2];
    f32x4 negm[2];
    float mref[2]; bool have[2];
    f32x4 lacc[2];
    bool robust_all = false;
    const s16x4 ones4 = {(short)0x3F80, (short)0x3F80, (short)0x3F80, (short)0x3F80};
    const int qpos0 = q0 + wid * 32 + l16;
    const unsigned* bmw = bmbase + ((size_t)(b * 256 + 8 * qb + wid)) * 8192;
#define FENCE __builtin_amdgcn_sched_barrier(0)
#define MASKKB(X, kb0, t) do { \
        if (MODE == 0) { const LAS float* bl = (const LAS float*)(L + L_BIAS); \
            if (cw - (t) >= 3) { const float bf = bl[191]; _Pragma("unroll") for (int kb = (kb0); kb < (kb0) + 2; ++kb) _Pragma("unroll") for (int qb2 = 0; qb2 < 2; ++qb2) _Pragma("unroll") for (int i = 0; i < 4; ++i) X[kb][qb2][i] += bf; } \
            else { _Pragma("unroll") for (int kb = (kb0); kb < (kb0) + 2; ++kb) _Pragma("unroll") for (int qb2 = 0; qb2 < 2; ++qb2) _Pragma("unroll") for (int i = 0; i < 4; ++i) { \
                    const int ra = qpos0 + 16 * qb2 - 64 * (t) - 16 * kb - Rrg - i; const int ia = (ra < -63 ? -63 : (ra > 128 ? 128 : ra)) + 63; X[kb][qb2][i] += bl[ia]; } } } \
        if (MODE == 1) { _Pragma("unroll") for (int kb = (kb0); kb < (kb0) + 2; ++kb) _Pragma("unroll") for (int qb2 = 0; qb2 < 2; ++qb2) { const u32x8 w = mw_[kb * 2 + qb2]; \
                _Pragma("unroll") for (int i = 0; i < 4; ++i) { const unsigned long long mk = ((unsigned long long)w[2 * i + 1] << 32) | (unsigned long long)w[2 * i]; X[kb][qb2][i] = cnd(NEGB, X[kb][qb2][i], mk); } } } } while (0)
#define EXPG(X, qb2, ks) do { _Pragma("unroll") for (int i = 0; i < 4; ++i) { X[2 * (ks)][qb2][i] = __builtin_amdgcn_exp2f(X[2 * (ks)][qb2][i]); X[2 * (ks) + 1][qb2][i] = __builtin_amdgcn_exp2f(X[2 * (ks) + 1][qb2][i]); } \
        pw[qb2][ks][0] = pg8::cvt_pk_bf16(X[2 * (ks)][qb2][0], X[2 * (ks)][qb2][1]) & vism_; pw[qb2][ks][1] = pg8::cvt_pk_bf16(X[2 * (ks)][qb2][2], X[2 * (ks)][qb2][3]) & vism_; \
        pw[qb2][ks][2] = pg8::cvt_pk_bf16(X[2 * (ks) + 1][qb2][0], X[2 * (ks) + 1][qb2][1]) & vism_; pw[qb2][ks][3] = pg8::cvt_pk_bf16(X[2 * (ks) + 1][qb2][2], X[2 * (ks) + 1][qb2][3]) & vism_; \
        lacc[qb2] = __builtin_amdgcn_mfma_f32_4x4x4bf16_1k(ones4, __builtin_bit_cast(s16x4, (u32x2){pw[qb2][ks][0], pw[qb2][ks][1]}), lacc[qb2], 0, 0, 0); \
        lacc[qb2] = __builtin_amdgcn_mfma_f32_4x4x4bf16_1k(ones4, __builtin_bit_cast(s16x4, (u32x2){pw[qb2][ks][2], pw[qb2][ks][3]}), lacc[qb2], 0, 0, 0); } while (0)
#define PVG(V, qb2, ks) do { const bf16x8 pf = __builtin_bit_cast(bf16x8, pw[qb2][ks]); \
        _Pragma("unroll") for (int dvb = 0; dvb < 4; ++dvb) O[dvb][qb2] = __builtin_amdgcn_mfma_f32_16x16x32_bf16(V[dvb], pf, O[dvb][qb2], 0, 0, 0); } while (0)
#define STEPF(SC, SN, t, s, FAST) do { \
        const cu8* mp_ = (const cu8*)(bmw + 64 * (t)); (void)mp_; \
        const LAS unsigned char* vf_ = vfb + (s) * TSLOT; \
        u32x8 mw_[8]; if (MODE == 1) { _Pragma("unroll") for (int v = 0; v < 8; ++v) mw_[v] = mp_[v]; }     \
        KLOAD(((s) + 1) & 3); \
        FENCE; \
        QKS(SN, 0); MASKKB(SC, 0, t); FENCE; \
        QKS(SN, 1); MASKKB(SC, 2, t); FENCE; \
        if (NS == 3) { QKS(SN, 2); } \
        float dlt[2] = {0.f, 0.f}; \
        if (!(FAST)) {                                          \
            _Pragma("unroll") for (int qb2 = 0; qb2 < 2; ++qb2) { float rm = SC[0][qb2][0]; \
                _Pragma("unroll") for (int kb = 0; kb < 4; ++kb) _Pragma("unroll") for (int i = 0; i < 4; ++i) rm = __builtin_fmaxf(rm, SC[kb][qb2][i]); \
                rm = rows_max(rm); rm = visc_ ? rm : NEGB;      \
                dlt[qb2] = have[qb2] ? (rm > RESC_THR ? rm : 0.f) : (rm > -1e20f ? rm : 0.f); \
                have[qb2] = have[qb2] || (rm > -1e20f); } } \
        VREAD(va, 0); \
        if (!(FAST)) { if (__any(dlt[0] != 0.f || dlt[1] != 0.f)) { _Pragma("unroll") for (int qb2 = 0; qb2 < 2; ++qb2) { mref[qb2] += dlt[qb2]; const float f = __builtin_amdgcn_exp2f(-dlt[qb2]); lacc[qb2] *= f; \
            const float nm = -mref[qb2]; negm[qb2] = (f32x4){nm, nm, nm, nm}; \
            _Pragma("unroll") for (int kb = 0; kb < 4; ++kb) { O[kb][qb2] *= f; SC[kb][qb2] -= dlt[qb2]; SN[kb][qb2] -= dlt[qb2]; } } } } \
        FENCE; \
        EXPG(SC, 0, 0); VREAD(vb, 1); FENCE; \
        PVG(va, 0, 0); EXPG(SC, 1, 0); FENCE; \
        PVG(va, 1, 0); EXPG(SC, 0, 1); FENCE; \
        PVG(vb, 0, 1); EXPG(SC, 1, 1); FENCE; \
        PVG(vb, 1, 1); if (dma_) DMA_T((t) + 3, ((s) + 3) & 3); \
    } while (0)
#define STEP(SC, SN, t, s, AV, FAST) do { \
        const bool dma_ = (t) + 3 <= t_hi; \
        const bool visc_ = (AV) ? true : VIS(t); const unsigned vism_ = visc_ ? 0xFFFFFFFFu : 0u;     \
        STEPF(SC, SN, t, s, FAST); \
        WAIT_BAR((t) + 3 <= t_hi); } while (0)
    f32x4 sa[4][2], sb[4][2];
    bf16x8 kfr[4][NS], va[4], vb[4]; u32x4 pw[2][2];
    float lsum[2];
    typedef unsigned u32x8 __attribute__((ext_vector_type(8))); typedef __attribute__((address_space(4))) const u32x8 cu8;
  for (;;) {
#pragma unroll
    for (int qb2 = 0; qb2 < 2; ++qb2) { negm[qb2] = (f32x4){0.f, 0.f, 0.f, 0.f}; lacc[qb2] = (f32x4){0.f, 0.f, 0.f, 0.f}; mref[qb2] = 0.f; have[qb2] = false;
#pragma unroll
        for (int kb = 0; kb < 4; ++kb) { O[kb][qb2] = (f32x4){0.f, 0.f, 0.f, 0.f}; sa[kb][qb2] = (f32x4){0.f, 0.f, 0.f, 0.f}; sb[kb][qb2] = (f32x4){0.f, 0.f, 0.f, 0.f}; } }
    DMA_T(t_lo, 0); DMA_T(t_lo + 1, 1); DMA_T(t_lo + 2, 2);
#pragma unroll
    for (int qb2 = 0; qb2 < 2; ++qb2)
#pragma unroll
        for (int s = 0; s < NS; ++s) asm volatile("" :: "v"(qr[qb2][s]));
    asm volatile("s_waitcnt vmcnt(0)" ::: "memory");
    WAIT_BAR(true);
    { KLOAD(0);
#pragma unroll
      for (int s = 0; s < NS; ++s) QKS(sa, s); }
    int t = t_lo;
#define PAIR(AV, FAST) do { const int s = (t - t_lo) & 3; STEP(sa, sb, t, s, AV, FAST); STEP(sb, sa, t + 1, (s + 1) & 3, AV, FAST); } while (0)
    if (MODE != 0) {
        for (; t < 4 * qb && (robust_all || !__all(have[0] && have[1])); t += 2) PAIR(true, false);
        for (; t < 4 * qb; t += 2) PAIR(true, true);
    }
    for (; t <= t_hi && (robust_all || !__all(have[0] && have[1])); t += 2) PAIR(false, false);
    for (; t <= t_hi; t += 2) PAIR(false, true);
#undef PAIR
    lsum[0] = rows_sum(lacc[0][0]); lsum[1] = rows_sum(lacc[1][0]);
    if (robust_all) break;
    if (__any(!(lsum[0] < 1.0e30f) || !(lsum[1] < 1.0e30f)) && lane == 0) F.MISC[4] = 1u;
    __syncthreads();
    const unsigned again = F.MISC[4];
    __syncthreads();
    if (again == 0u) break;
    if (tid == 0) F.MISC[4] = 0u;
    robust_all = true;
  }
#undef STEP
#undef STEPF
#undef FENCE
#undef QKS
#undef MASKKB
#undef VREAD
#undef EXPG
#undef PVG
#undef KLOAD
#undef VIS
#undef DMA_T
#undef WAIT_BAR
#pragma unroll
    for (int qb2 = 0; qb2 < 2; ++qb2) {
        const float linv = __builtin_amdgcn_rcpf(lsum[qb2]);
        bf16_t* orow = QO + (rowb + q0 + wid * 32 + 16 * qb2 + l16) * QO_PITCH + qcol + 4 * rg;
#pragma unroll
        for (int dvb = 0; dvb < 4; ++dvb) {
            u32x2 w; w.x = pg8::cvt_pk_bf16(O[dvb][qb2][0] * linv, O[dvb][qb2][1] * linv); w.y = pg8::cvt_pk_bf16(O[dvb][qb2][2] * linv, O[dvb][qb2][3] * linv);
            if (o8) { float q[4];
#pragma unroll
                for (int i = 0; i < 4; ++i) q[i] = __builtin_fminf(__builtin_fmaxf(O[dvb][qb2][i] * (linv * O_F8_SCALE), -448.0f), 448.0f);
                int w8 = 0; w8 = __builtin_amdgcn_cvt_pk_fp8_f32(q[0], q[1], w8, false); w8 = __builtin_amdgcn_cvt_pk_fp8_f32(q[2], q[3], w8, true);
                if (do_store) *(unsigned*)(o8 + (rowb + q0 + wid * 32 + 16 * qb2 + l16) * (size_t)DM + qcol + 4 * rg + 16 * dvb) = (unsigned)w8; }
            else if (do_store) *(u32x2*)(orow + 16 * dvb) = w;
        }
    }
}
}
namespace sel {
constexpr int CAP = 256;
constexpr int L_HIST = 0, L_WORDS = 65536, L_WT = 98304, L_THR = 99328, L_CNT = 99840, L_PFX = 99968, L_SUB = 100224, L_END = 108416;
__device__ __forceinline__ unsigned wave_suffix_incl(unsigned v) {
    unsigned t = v;
    t += (unsigned)__builtin_amdgcn_update_dpp(0, (int)t, 0x111, 0xF, 0xF, false);
    t += (unsigned)__builtin_amdgcn_update_dpp(0, (int)t, 0x112, 0xF, 0xF, false);
    t += (unsigned)__builtin_amdgcn_update_dpp(0, (int)t, 0x114, 0xF, 0xF, false);
    t += (unsigned)__builtin_amdgcn_update_dpp(0, (int)t, 0x118, 0xF, 0xF, false);
    t += (unsigned)__builtin_amdgcn_update_dpp(0, (int)t, 0x142, 0xA, 0xF, false);
    t += (unsigned)__builtin_amdgcn_update_dpp(0, (int)t, 0x143, 0xC, 0xF, false);
    const unsigned tot = (unsigned)__builtin_amdgcn_readlane((int)t, 63);
    return tot - t + v;
}
__device__ __forceinline__ unsigned mono(float s) { const unsigned u = __builtin_bit_cast(unsigned, s); return u ^ ((unsigned)((int)u >> 31) | 0x80000000u); }
typedef short s16x2 __attribute__((ext_vector_type(2)));
__device__ __forceinline__ void score_tile(const bf16x8 (&af)[2], const bf16x8 (&bf)[2], const bf16x8 (&wa)[2], float& sA, float& sB) {
    f32x16 c = {};
    c = __builtin_amdgcn_mfma_f32_32x32x16_bf16(af[0], bf[0], c, 0, 0, 0);
    c = __builtin_amdgcn_mfma_f32_32x32x16_bf16(af[1], bf[1], c, 0, 0, 0);
    f32x16 o = {};
#pragma unroll
    for (int s = 0; s < 2; ++s) {
        u32x4 pk;
#pragma unroll
        for (int m = 0; m < 4; ++m) { const unsigned u = pg8::cvt_pk_bf16(c[8 * s + 2 * m], c[8 * s + 2 * m + 1]);
            const s16x2 v = __builtin_elementwise_max(__builtin_bit_cast(s16x2, u), (s16x2){0, 0});
            pk[m] = __builtin_bit_cast(unsigned, v); }
        o = __builtin_amdgcn_mfma_f32_32x32x16_bf16(wa[s], __builtin_bit_cast(bf16x8, pk), o, 0, 0, 0);
    }
    sA = o[0]; sB = o[1];
}
__device__ __forceinline__ void make_wa(const LAS float* WT, int qb4, int r32, int hi, bf16x8 (&wa)[2]) {
    const int gl = (r32 == 0) ? 0 : (r32 == 1) ? 1 : (r32 == 4) ? 2 : (r32 == 5) ? 3 : -1;
    const f32x4 w4 = *(const LAS f32x4*)(WT + (qb4 + (gl < 0 ? 0 : gl)) * 8 + 4 * hi);
    const unsigned p0 = gl < 0 ? 0u : pg8::cvt_pk_bf16(w4[0], w4[1]), p1 = gl < 0 ? 0u : pg8::cvt_pk_bf16(w4[2], w4[3]);
    u32x4 x0 = {0u, 0u, 0u, 0u}, x1 = {0u, 0u, 0u, 0u};
    if (gl == 0) { x0[0] = p0; x0[1] = p1; } else if (gl == 1) { x0[2] = p0; x0[3] = p1; } else if (gl == 2) { x1[0] = p0; x1[1] = p1; } else if (gl == 3) { x1[2] = p0; x1[3] = p1; }
    wa[0] = __builtin_bit_cast(bf16x8, x0); wa[1] = __builtin_bit_cast(bf16x8, x1);
}
__device__ __forceinline__ void sel_unit(Frame& F, int b, int qg, unsigned* bmbase, const bf16_t* wiw  ) {
    int tid_ = threadIdx.x; asm volatile("" : "+v"(tid_));
    const int tid = tid_, lane = tid & 63, r32 = lane & 31, hi = lane >> 5, wid = __builtin_amdgcn_readfirstlane(tid >> 6);
    LAS unsigned char* const L = F.lds; unsigned char* const ws = opaque_global(F.ws);
    const int n = 64 * ((qg >> 1) + 1), ntile = n / 32;
    const size_t rowb = (size_t)b * SEQ; const size_t q0 = rowb + 32 * qg;
    const bf16_t* const IQ = (const bf16_t*)(ws + WS_IQ); const bf16_t* const IK = (const bf16_t*)(ws + WS_IK);
    LAS float* const WT = (LAS float*)(L + L_WT);
    LAS unsigned* const THR = (LAS unsigned*)(L + L_THR);
    LAS unsigned* const CNT = (LAS unsigned*)(L + L_CNT);
    LAS unsigned* const PFX = (LAS unsigned*)(L + L_PFX);
    LAS unsigned* const WORDS = (LAS unsigned*)(L + L_WORDS);
    {
        const bf16_t* const XBp = (const bf16_t*)(ws + WS_XB); const float* const STX = (const float*)(ws + WS_STATX);
        LAS float* const PART = (LAS float*)(L + L_HIST);
        float rsq_ = 0.f; if (tid < 256) rsq_ = pg8::row_rs(STX, (int)(q0 + (tid >> 3)));
        bf16x8 wa_[8], xb_[8];
#pragma unroll
        for (int s = 0; s < 8; ++s) { const int k0 = 16 * (8 * wid + s) + 8 * hi; wa_[s] = *(const bf16x8*)(wiw + (size_t)r32 * DM + k0); xb_[s] = *(const bf16x8*)(XBp + (q0 + r32) * DM + k0); }
        f32x16 c = {};
#pragma unroll
        for (int s = 0; s < 8; ++s) c = __builtin_amdgcn_mfma_f32_32x32x16_bf16(wa_[s], xb_[s], c, 0, 0, 0);
        *(LAS f32x4*)(PART + (wid * 32 + r32) * 8 + 4 * hi) = (f32x4){c[0], c[1], c[2], c[3]};
        __syncthreads();
        if (tid < 256) { const int q = tid >> 3, h = tid & 7; float sm = 0.f;
#pragma unroll
            for (int w = 0; w < 8; ++w) sm += PART[(w * 32 + q) * 8 + h];
            WT[tid] = sm * rsq_; }
    }
    if (tid < 32) { THR[4 * tid] = 1u; THR[4 * tid + 1] = 0u; THR[4 * tid + 2] = 0u; CNT[tid] = 0u; }
    __syncthreads();
    const bf16_t* const ikb = IK + (rowb + r32) * 32 + 8 * hi;
    if (n > 256) {
        for (int sub = 0; sub < 4; ++sub) {
            bf16x8 af[2][2], w[2][2];
#pragma unroll
            for (int mt = 0; mt < 2; ++mt) {
#pragma unroll
                for (int ks = 0; ks < 2; ++ks) af[mt][ks] = *(const bf16x8*)(IQ + (q0 + 8 * sub + 4 * mt) * 256 + r32 * 32 + 16 * ks + 8 * hi);
                make_wa(WT, 8 * sub + 4 * mt, r32, hi, w[mt]);
            }
            if (tid < 8) { PFX[8 * tid] = 0u; PFX[8 * tid + 1] = 0u; PFX[8 * tid + 2] = 0u; PFX[8 * tid + 3] = 0u; }
            for (int level = 0; level < 3; ++level) {
                for (int i = tid; i < 16384; i += 512) ((LAS unsigned*)(L + L_HIST))[i] = 0u;
                __syncthreads();
                const int sh = (level == 0) ? 20 : (level == 1 ? 8 : 0);
                const unsigned bmask = (level == 2) ? 0xFFu : 0xFFFu;
                unsigned pfxr[2][2], plenr[2][2];
#pragma unroll
                for (int mt = 0; mt < 2; ++mt)
#pragma unroll
                    for (int j = 0; j < 2; ++j) { const int qs = 4 * mt + 2 * hi + j; pfxr[mt][j] = PFX[8 * qs]; plenr[mt][j] = PFX[8 * qs + 1]; }
#define SEL_LOADBF(dst, k) do { const int k_ = (k) < ntile ? (k) : (ntile - 1); dst[0] = *(const bf16x8*)(ikb + (size_t)k_ * 1024); dst[1] = *(const bf16x8*)(ikb + (size_t)k_ * 1024 + 16); } while (0)
#define SEL_P1_TILE(bf) do { float sc_[2][2];                \
                        _Pragma("unroll") for (int mt = 0; mt < 2; ++mt) score_tile(af[mt], bf, w[mt], sc_[mt][0], sc_[mt][1]); \
                        _Pragma("unroll") for (int mt = 0; mt < 2; ++mt) { \
                        _Pragma("unroll") for (int j = 0; j < 2; ++j) { const unsigned key = mono(sc_[mt][j]); const int qs = 4 * mt + 2 * hi + j; const unsigned pfx = pfxr[mt][j], plen = plenr[mt][j]; \
                            const bool match = (plen == 0u) || ((key >> (32u - plen)) == pfx); \
                            if (match) { const unsigned bin = (key >> sh) & bmask; \
                                __hip_atomic_fetch_add((LAS unsigned*)(L + L_HIST + qs * 8192 + (bin >> 1) * 4), 1u << (16 * (bin & 1)), __ATOMIC_RELAXED, __HIP_MEMORY_SCOPE_WORKGROUP); } } } } while (0)
#define SEL_P1_TILE0(bf) do { float sc_[2][2]; __builtin_amdgcn_s_setprio(1); \
                        _Pragma("unroll") for (int mt = 0; mt < 2; ++mt) score_tile(af[mt], bf, w[mt], sc_[mt][0], sc_[mt][1]); \
                        __builtin_amdgcn_s_setprio(0); \
                        _Pragma("unroll") for (int mt = 0; mt < 2; ++mt) { \
                        _Pragma("unroll") for (int j = 0; j < 2; ++j) { const unsigned key = __builtin_bit_cast(unsigned, sc_[mt][j]); \
                                __hip_atomic_fetch_add((LAS unsigned*)(hb0[mt][j] + ((key >> 21) << 2)), 1u << ((key >> 16) & 16u), __ATOMIC_RELAXED, __HIP_MEMORY_SCOPE_WORKGROUP); } } } while (0)
                {
                    bf16x8 bA[2], bB[2]; SEL_LOADBF(bA, wid); SEL_LOADBF(bB, wid + 8);
                    if (level == 0) {
                        LAS unsigned char* hb0[2][2];
#pragma unroll
                        for (int mt = 0; mt < 2; ++mt)
#pragma unroll
                            for (int j = 0; j < 2; ++j) hb0[mt][j] = L + L_HIST + (4 * mt + 2 * hi + j) * 8192;
                        for (int kt = wid; kt < ntile; kt += 16) {
                            SEL_P1_TILE0(bA); SEL_LOADBF(bA, kt + 16);
                            if (kt + 8 < ntile) { SEL_P1_TILE0(bB); } SEL_LOADBF(bB, kt + 24);
                        }
                    } else
                    for (int kt = wid; kt < ntile; kt += 16) {
                        SEL_P1_TILE(bA); SEL_LOADBF(bA, kt + 16);
                        if (kt + 8 < ntile) { SEL_P1_TILE(bB); } SEL_LOADBF(bB, kt + 24);
                    }
                }
                __syncthreads();
                {
                    const int qs = wid; const LAS unsigned short* hq = (const LAS unsigned short*)(L + L_HIST + qs * 8192);
                    const unsigned above = PFX[8 * qs + 2]; const unsigned need = 256u - above;
                    unsigned tl = 0;
                    const int seg = (level == 0) ? (lane >= 32 ? lane - 32 : 63 - lane) : lane;
                    for (int i = 0; i < 32; ++i) { const unsigned v = *(const LAS unsigned*)(hq + 64 * seg + 2 * i); tl += (v & 0xFFFFu) + (v >> 16); }
                    const unsigned suf = wave_suffix_incl(tl);
                    const unsigned sabove = suf - tl;
                    const bool cross = (sabove < need && need <= sabove + tl);
                    const unsigned long long cm = __ballot(cross);
                    const int cl = cm ? (int)__builtin_ctzll(cm) : 63;
                    const unsigned sab0 = __builtin_amdgcn_readlane(sabove, cl);
                    const unsigned cb = hq[(level == 0) ? (cl >= 32 ? 64 * (cl - 32) + lane : 4095 - 64 * cl - lane) : (64 * cl + lane)];
                    const unsigned suf2 = wave_suffix_incl(cb);
                    const unsigned ab2 = sab0 + suf2 - cb;
                    if (ab2 < need && need <= ab2 + cb) { const unsigned bits = (level == 2) ? 8u : 12u;
                        PFX[8 * qs + 4] = (PFX[8 * qs] << bits) | (unsigned)(64 * cl + lane); PFX[8 * qs + 5] = PFX[8 * qs + 1] + bits; PFX[8 * qs + 6] = above + ab2; PFX[8 * qs + 7] = cb; }
                }
                __syncthreads();
                if (tid < 8) { PFX[8 * tid] = PFX[8 * tid + 4]; PFX[8 * tid + 1] = PFX[8 * tid + 5]; PFX[8 * tid + 2] = PFX[8 * tid + 6]; PFX[8 * tid + 3] = PFX[8 * tid + 7]; }
                __syncthreads();
                unsigned mx = 0;
#pragma unroll
                for (int q = 0; q < 8; ++q) { const unsigned cq = PFX[8 * q + 3]; mx = cq > mx ? cq : mx; }
                if (mx <= (unsigned)CAP) break;
            }
            if (tid < 8) { const unsigned pfx = PFX[8 * tid], plen = PFX[8 * tid + 1]; const unsigned lo = (plen >= 32u) ? pfx : (pfx << (32u - plen));
                const unsigned hi_k = (plen >= 32u) ? pfx : (lo | ((1u << (32u - plen)) - 1u));
                THR[4 * (8 * sub + tid)] = lo; THR[4 * (8 * sub + tid) + 1] = hi_k; THR[4 * (8 * sub + tid) + 2] = 256u - PFX[8 * tid + 2]; }
            __syncthreads();
        }
    }
    LAS unsigned* const CAND = (LAS unsigned*)(L + L_HIST);
    for (int hf = 0; hf < 2; ++hf) {
        bf16x8 af[4][2], w[4][2]; unsigned tlo[4][2], thi[4][2];
#pragma unroll
        for (int mt = 0; mt < 4; ++mt) {
#pragma unroll
            for (int ks = 0; ks < 2; ++ks) af[mt][ks] = *(const bf16x8*)(IQ + (q0 + 16 * hf + 4 * mt) * 256 + r32 * 32 + 16 * ks + 8 * hi);
            make_wa(WT, 16 * hf + 4 * mt, r32, hi, w[mt]);
#pragma unroll
            for (int j = 0; j < 2; ++j) { const int q = 16 * hf + 4 * mt + 2 * hi + j; tlo[mt][j] = THR[4 * q]; thi[mt][j] = THR[4 * q + 1]; }
        }
#define SEL_P2_TILE(bf, kt_) do { unsigned bits = 0u; float sc_[4][2]; \
            __builtin_amdgcn_s_setprio(1); \
            _Pragma("unroll") for (int mt = 0; mt < 4; ++mt) score_tile(af[mt], bf, w[mt], sc_[mt][0], sc_[mt][1]); \
            __builtin_amdgcn_s_setprio(0); \
            _Pragma("unroll") for (int mt = 0; mt < 4; ++mt) { \
                _Pragma("unroll") for (int j = 0; j < 2; ++j) { const unsigned key = mono(sc_[mt][j]); const bool selq = key > thi[mt][j]; bits |= selq ? (1u << (4 * mt + j)) : 0u; \
                    if (!selq && key >= tlo[mt][j]) { const int q = 16 * hf + 4 * mt + 2 * hi + j; \
                        const unsigned slot = __hip_atomic_fetch_add(CNT + q, 1u, __ATOMIC_RELAXED, __HIP_MEMORY_SCOPE_WORKGROUP); \
                        if (slot < (unsigned)CAP) { CAND[(q * CAP + slot) * 2] = key; CAND[(q * CAP + slot) * 2 + 1] = (unsigned)(32 * (kt_) + r32); } } } } \
            bits <<= (2 * hi); unsigned bx = bits, by = bits; att::swap32u(bx, by); const unsigned tot = bx | by; \
            if (hi == 0) ((LAS unsigned short*)WORDS)[(32 * (kt_) + r32) * 2 + hf] = (unsigned short)tot; } while (0)
        {
            bf16x8 bA[2], bB[2]; SEL_LOADBF(bA, wid); SEL_LOADBF(bB, wid + 8);
            for (int kt = wid; kt < ntile; kt += 16) {
                SEL_P2_TILE(bA, kt); SEL_LOADBF(bA, kt + 16);
                if (kt + 8 < ntile) { SEL_P2_TILE(bB, kt + 8); } SEL_LOADBF(bB, kt + 24);
            }
        }
    }
    __syncthreads();
    {
        LAS unsigned* const SUB = (LAS unsigned*)(L + L_SUB) + wid * 256;
        for (int qi = 0; qi < 4; ++qi) {
            const int q = wid + 8 * qi;
            unsigned cnt = __builtin_amdgcn_readfirstlane(CNT[q]); cnt = cnt > (unsigned)CAP ? 0u : cnt;
            const unsigned need = __builtin_amdgcn_readfirstlane(THR[4 * q + 2]);
            if (cnt == 0u || need == 0u) continue;
            const unsigned span = __builtin_amdgcn_readfirstlane(THR[4 * q + 1] - THR[4 * q]);
            const int s2 = (span >= 0xFFFFFu) ? 12 : 0;
            unsigned key[4], idx[4], sb[4]; bool val[4];
#pragma unroll
            for (int i = 0; i < 4; ++i) { const unsigned c = lane + 64 * i; val[i] = c < cnt; const u32x2 e = *(const LAS u32x2*)(CAND + (q * CAP + (val[i] ? c : 0u)) * 2); key[i] = e.x; idx[i] = e.y; sb[i] = (e.x >> s2) & 0xFFu; SUB[lane + 64 * i] = 0u; }
#pragma unroll
            for (int i = 0; i < 4; ++i) if (val[i]) __hip_atomic_fetch_add(SUB + sb[i], 1u, __ATOMIC_RELAXED, __HIP_MEMORY_SCOPE_WORKGROUP);
            const u32x4 hb = *(const LAS u32x4*)(SUB + 4 * lane);
            const unsigned tl = (hb[0] + hb[1]) + (hb[2] + hb[3]);
            const unsigned suf = wave_suffix_incl(tl);
            const unsigned sabove = suf - tl;
            const bool cross = (sabove < need && need <= sabove + tl);
            unsigned b2 = 0u, ab2 = 0u;
            if (cross) { unsigned acc = sabove; b2 = 4u * lane + 3u; ab2 = acc;
#pragma unroll
                for (int e = 3; e >= 0; --e) { if (acc + hb[e] >= need) { b2 = 4u * lane + e; ab2 = acc; break; } acc += hb[e]; } }
            const unsigned long long cm = __ballot(cross);
            const int cl = cm ? (int)__builtin_ctzll(cm) : 0;
            b2 = __builtin_amdgcn_readlane(b2, cl); ab2 = __builtin_amdgcn_readlane(ab2, cl);
            const unsigned need2 = need - ab2;
            bool same[4]; unsigned rank[4];
#pragma unroll
            for (int i = 0; i < 4; ++i) { same[i] = val[i] && sb[i] == b2; rank[i] = 0u; }
#pragma unroll
            for (int i2 = 0; i2 < 4; ++i2) {
                unsigned long long m = __ballot(same[i2]);
                while (m) { const int sl = (int)__builtin_ctzll(m); m &= m - 1ull;
                    const unsigned kj = __builtin_amdgcn_readlane(key[i2], sl), ij = __builtin_amdgcn_readlane(idx[i2], sl);
#pragma unroll
                    for (int i = 0; i < 4; ++i) rank[i] += (same[i] && (kj > key[i] || (kj == key[i] && ij < idx[i]))) ? 1u : 0u; }
            }
#pragma unroll
            for (int i = 0; i < 4; ++i) if (val[i] && (sb[i] > b2 || (same[i] && rank[i] < need2))) __hip_atomic_fetch_or(WORDS + idx[i], 1u << q, __ATOMIC_RELAXED, __HIP_MEMORY_SCOPE_WORKGROUP);
        }
    }
    __syncthreads();
    unsigned* const bm = bmbase + ((size_t)(b * 256 + qg)) * 8192;
    for (int o = tid; o < n; o += 512) { const int T = o >> 6, w = o & 63, mi = w >> 1, hh = w & 1, kb = mi >> 3, qb2 = (mi >> 2) & 1, i = mi & 3;
        const int k0 = 64 * T + 16 * kb + 4 * hh + i; const unsigned wa = WORDS[k0], wb = WORDS[k0 + 8];
        bm[o] = ((wa >> (16 * qb2)) & 0xFFFFu) | (((wb >> (16 * qb2)) & 0xFFFFu) << 16); }
    __syncthreads();
}
}
constexpr int PH_PRO = 0, PH_L0 = 1, PH_PER_LAYER = 8, PH_FNORM = PH_L0 + DEPTH * PH_PER_LAYER, NPH = PH_FNORM + 1;
enum { L_GU1 = 0, L_D1, L_WIN, L_MIXA, L_MIXB, L_WOUT, L_GU2, L_D2 };
#ifndef PROBE_DUP
#define PROBE_DUP -1
#endif
#define NREP(kind) ((PROBE_DUP == (kind) || ((kind) == L_MIXB && (PROBE_DUP == 41 || PROBE_DUP == 42))) ? 2 : 1)
#ifndef MK_ONE_LAUNCH
#define MK_ONE_LAUNCH 1
#endif
__device__ __forceinline__ int queue_next(Frame& F, int qid) {
    if (threadIdx.x == 0) F.MISC[0] = __hip_atomic_fetch_add(F.ctl + CW_Q + 64 * qid, 1u, RLX_AGENT);
    __syncthreads(); const int v = __builtin_amdgcn_readfirstlane((int)F.MISC[0]); __syncthreads(); return v;
}
__device__ __forceinline__ int opaque_bx() { int b = blockIdx.x; asm volatile("" : "+s"(b)); return b; }
__device__ __forceinline__ void zero_o(Frame& F, int b, int qb, int col) {
    unsigned char* const ws_ = opaque_global(F.ws); int tid = threadIdx.x; asm volatile("" : "+v"(tid)); bf16_t* QO = (bf16_t*)(ws_ + WS_QO);
    for (int i = tid; i < 256 * 8; i += 512) { const int r = i >> 3, c = (i & 7) * 8; *(u32x4*)(QO + ((size_t)b * SEQ + qb * 256 + r) * QO_PITCH + col + c) = (u32x4){0u, 0u, 0u, 0u}; }
}
#ifndef PAIR_DEAL
#define PAIR_DEAL 0
#endif
#if PAIR_DEAL
#define SINIT init_pair
#else
#define SINIT init
#endif
struct Args { In in; float* out; unsigned char* ws; int ph_lo, ph_hi; };
#define IN(k) (lo <= (k) && (k) < hi)
#define SEAM(k) do { if (IN(k) && IN((k) + 1)) xcd_barrier(bar); } while (0)
#define PHASE_PTRS unsigned char* const wsp = opaque_global(F.ws); float* const xout = opaque_global(args.out); \
    bf16_t* const XB = (bf16_t*)(wsp + WS_XB); float* const STATX = (float*)(wsp + WS_STATX); float* const STATC = (float*)(wsp + WS_STATC); bf16_t* const ACT = (bf16_t*)(wsp + WS_ACT); \
    unsigned char* const wl = wsp + WS_W + (size_t)l * W_LAYER; (void)XB; (void)STATX; (void)STATC; (void)ACT; (void)wl; (void)xout
template <int L_> __device__ __forceinline__ void layer_body(Frame& F, const Args& args, const XcdBarrier& bar, const int lo, const int hi) {
    constexpr int l = L_;
        const int pb = PH_L0 + l * PH_PER_LAYER;
        if (IN(pb + L_GU1)) { PHASE_PTRS;
            pg8::Gemm g{XB, (const bf16_t*)(wl + W_GU1), M, 2 * FF, DM, DM}; pg8::StaticOrder S; S.SINIT(M, 2 * FF, F.G, opaque_bx());
            constexpr bool f8 = d_is_f8(l, 0); constexpr bool gf8 = gu_is_f8(l, 0);
            if constexpr (gf8) {
                pg8::Gemm g8{(const bf16_t*)xout, (const bf16_t*)(wl + W_GU1), M, 2 * FF, DM / 2, DM / 2};
                pg8::EpiSwiGLU<f8> E{(unsigned char*)ACT, STATX, (LAS float*)(F.lds + pg8::RS_TAB_OFF), 1.0f / (X_F8_SCALE * WGU_F8_SCALE)};
                pg8::gemm_phase<pg8::EpiSwiGLU<f8>, pg8::StaticOrder, true, true, true>(F.lds + RING_OFF, g8, S, E);
            } else {
            pg8::EpiSwiGLU<f8> E{(unsigned char*)ACT, STATX, (LAS float*)(F.lds + pg8::RS_TAB_OFF), 1.0f};
            for (int rep = 0; rep < NREP(L_GU1); ++rep)
            pg8::gemm_phase<pg8::EpiSwiGLU<f8>, pg8::StaticOrder, true, true>(F.lds + RING_OFF, g, S, E);
            }
            SEAM(pb + L_GU1);
        }
        if (IN(pb + L_D1)) { PHASE_PTRS;
            constexpr bool f8 = d_is_f8(l, 0); constexpr int KD = f8 ? FF / 2 : FF;
            pg8::Gemm g{ACT, (const bf16_t*)(wl + W_D1), M, DM, KD, KD}; pg8::StaticOrder S; S.SINIT(M, DM, F.G, opaque_bx());
            pg8::EpiResid E{XB, STATX, f8 ? 0.5f / (ACT_F8_SCALE * WD_F8_SCALE) : 0.5f, win_is_f8(l) ? (unsigned char*)xout + DOUT_XB8 : nullptr};
            pg8::gemm_phase<pg8::EpiResid, pg8::StaticOrder, true, true, f8>(F.lds + RING_OFF, g, S, E);
            if (NREP(L_D1) == 2) { pg8::EpiResid E2{XB, STATX, 0.0f}; __syncthreads(); pg8::gemm_phase<pg8::EpiResid, pg8::StaticOrder, true, true, f8>(F.lds + RING_OFF, g, S, E2); }
            SEAM(pb + L_D1);
        }
        if (IN(pb + L_WIN)) { PHASE_PTRS;
            if constexpr (win_is_f8(l)) {
                { pg8::Gemm g8{(const bf16_t*)((unsigned char*)xout + DOUT_XB8), (const bf16_t*)(wl + W_IN), M, WIN_F8_TILES * 256, DM / 2, DM / 2}; pg8::StaticOrder S; S.SINIT(M, WIN_F8_TILES * 256, F.G, opaque_bx());
                  pg8::EpiScatter<true> E{WIN_DESC, wsp, STATX, 16, 0, 16, 1.0f / 1024.0f, STATC, (LAS float*)(F.lds + pg8::RS_TAB_OFF), 0, 1.0f / (X_F8_SCALE * WIN_F8_SCALE)};
                  pg8::gemm_phase<pg8::EpiScatter<true>, pg8::StaticOrder, true, true, true>(F.lds + RING_OFF, g8, S, E); }
                __syncthreads();
                { pg8::Gemm gb{XB, (const bf16_t*)(wl + W_IN) + (size_t)WIN_F8_TILES * 256 * DM, M, NIN - WIN_F8_TILES * 256, DM, DM}; pg8::StaticOrder S; S.SINIT(M, NIN - WIN_F8_TILES * 256, F.G, opaque_bx());
                  pg8::EpiScatter<true> E{WIN_DESC, wsp, STATX, 16, 0, 16, 1.0f / 1024.0f, STATC, (LAS float*)(F.lds + pg8::RS_TAB_OFF), WIN_F8_TILES, 1.0f};
                  pg8::gemm_phase<pg8::EpiScatter<true>, pg8::StaticOrder, true, true>(F.lds + RING_OFF, gb, S, E); }
            } else {
            pg8::Gemm g{XB, (const bf16_t*)(wl + W_IN), M, NIN, DM, DM}; pg8::StaticOrder S; S.SINIT(M, NIN, F.G, opaque_bx());
            pg8::EpiScatter<true> E{WIN_DESC, wsp, STATX, 16, 0, 16, 1.0f / 1024.0f, STATC, (LAS float*)(F.lds + pg8::RS_TAB_OFF)};
            for (int rep = 0; rep < NREP(L_WIN); ++rep)
            pg8::gemm_phase<pg8::EpiScatter<true>, pg8::StaticOrder, true, true>(F.lds + RING_OFF, g, S, E);
            }
            SEAM(pb + L_WIN);
        }
        if (IN(pb + L_MIXA)) { PHASE_PTRS;
#if !defined(DBG_NO_C)
            const bool mla_split = (F.G == 2 * (M / pg8::BM)); const int mla_pm = F.vcu >> 1, mla_kind = F.vcu & 1;
            if (!mla_split || mla_kind == 0)
            { pg8::Gemm g{(const bf16_t*)(wsp + WS_CQ), (const bf16_t*)(wl + W_UQ), M, 512, 384, 384}; pg8::StaticOrder S; if (mla_split) S.init_panel(M, 512, mla_pm); else S.SINIT(M, 512, F.G, opaque_bx());
              pg8::EpiScatter<false> E{WUQ_DESC, wsp, STATC, 32, 0, 12, 1.0f / 384.0f, nullptr, (LAS float*)(F.lds + pg8::RS_TAB_OFF)};
              pg8::gemm_phase<pg8::EpiScatter<false>, pg8::StaticOrder, true, true>(F.lds + RING_OFF, g, S, E); }
            if (!mla_split || mla_kind == 1)
            { pg8::Gemm g{(const bf16_t*)(wsp + WS_CKV), (const bf16_t*)(wl + W_UKV), M, 768, 256, 256}; pg8::StaticOrder S; if (mla_split) S.init_panel(M, 768, mla_pm); else S.SINIT(M, 768, F.G, opaque_bx());
              pg8::EpiScatter<false> E{WUKV_DESC, wsp, STATC, 32, 16, 8, 1.0f / 256.0f, nullptr, (LAS float*)(F.lds + pg8::RS_TAB_OFF)};
              pg8::gemm_phase<pg8::EpiScatter<false>, pg8::StaticOrder, true, true>(F.lds + RING_OFF, g, S, E); }
#endif
            const float* biasl = args.in.p[7] + l * 6 * 192; unsigned* const bml = (unsigned*)(wsp + WS_BM) + (size_t)l * (8u << 20);
            for (int rep = 0; rep < NREP(L_MIXA); ++rep)
            for (;;) {
                const int it = queue_next(F, 2 * l + 8 * rep);
                if (it >= 1024 + 768) break;
                if (it < 1024) {
#if !defined(DBG_NO_B)
                    sel::sel_unit(F, it & 3, 255 - (it >> 2), bml, (const bf16_t*)(wl + W_IW));
#endif
                } else {
                    const int i2 = it - 1024, r = i2 % 24;
#if !defined(DBG_NO_A)
                    att::attn_unit<0>(F, r / 6, r % 6, 31 - i2 / 24, biasl, nullptr, rep == 0, wo_is_f8(l) ? (unsigned char*)xout + DOUT_O8 : nullptr);
#else
                    zero_o(F, r / 6, 31 - i2 / 24, 64 * (r % 6));
#endif
                }
            }
            SEAM(pb + L_MIXA);
        }
        if (IN(pb + L_MIXB)) { PHASE_PTRS;
            const unsigned* const bml = (const unsigned*)(wsp + WS_BM) + (size_t)l * (8u << 20);
            for (int rep = 0; rep < NREP(L_MIXB); ++rep)
            for (;;) {
                const int it = queue_next(F, 2 * l + 1 + 8 * rep);
                if (it >= 1280) break;
                const int qb = 31 - it / 40, r = it % 40, r2 = r % 20;
                if (rep == 1 && ((PROBE_DUP == 41 && r >= 20) || (PROBE_DUP == 42 && r < 20))) continue;
                if (r < 20) {
#if !defined(DBG_NO_C)
                    att::attn_unit<2>(F, r2 / 5, r2 % 5, qb, nullptr, nullptr, rep == 0, wo_is_f8(l) ? (unsigned char*)xout + DOUT_O8 : nullptr);
#else
                    zero_o(F, r2 / 5, qb, 704 + 64 * (r2 % 5));
#endif
                } else {
#if !defined(DBG_NO_B) && !defined(DBG_NO_BATT)
                    att::attn_unit<1>(F, r2 / 5, r2 % 5, qb, nullptr, bml, rep == 0, wo_is_f8(l) ? (unsigned char*)xout + DOUT_O8 : nullptr);
#else
                    zero_o(F, r2 / 5, qb, 384 + 64 * (r2 % 5));
#endif
                }
            }
            SEAM(pb + L_MIXB);
        }
        if (IN(pb + L_WOUT)) { PHASE_PTRS;
            constexpr bool of8 = wo_is_f8(l);
            pg8::Gemm g{of8 ? (const bf16_t*)((unsigned char*)xout + DOUT_O8) : (const bf16_t*)(wsp + WS_QO), (const bf16_t*)(wl + W_OUT), M, DM, of8 ? DM / 2 : DM, of8 ? DM / 2 : QO_PITCH}; pg8::StaticOrder S; S.SINIT(M, DM, F.G, opaque_bx());
            pg8::EpiResid E{XB, STATX, of8 ? 1.0f / (O_F8_SCALE * WO_F8_SCALE) : 1.0f, gu_is_f8(l, 1) ? (unsigned char*)xout + DOUT_XB8 : nullptr};
            pg8::gemm_phase<pg8::EpiResid, pg8::StaticOrder, true, true, of8>(F.lds + RING_OFF, g, S, E);
            if (NREP(L_WOUT) == 2) { pg8::EpiResid E2{XB, STATX, 0.0f}; __syncthreads(); pg8::gemm_phase<pg8::EpiResid, pg8::StaticOrder, true, true>(F.lds + RING_OFF, g, S, E2); }
            if (PROBE_DUP == 200) { for (int rep = 0; rep < 8; ++rep) xcd_barrier(bar); }
            SEAM(pb + L_WOUT);
        }
        if (IN(pb + L_GU2)) { PHASE_PTRS;
            pg8::Gemm g{XB, (const bf16_t*)(wl + W_GU2), M, 2 * FF, DM, DM}; pg8::StaticOrder S; S.SINIT(M, 2 * FF, F.G, opaque_bx());
            constexpr bool f8 = d_is_f8(l, 1); constexpr bool gf8 = gu_is_f8(l, 1);
            if constexpr (gf8) {
                pg8::Gemm g8{(const bf16_t*)xout, (const bf16_t*)(wl + W_GU2), M, 2 * FF, DM / 2, DM / 2};
                pg8::EpiSwiGLU<f8> E{(unsigned char*)ACT, STATX, (LAS float*)(F.lds + pg8::RS_TAB_OFF), 1.0f / (X_F8_SCALE * WGU_F8_SCALE)};
                pg8::gemm_phase<pg8::EpiSwiGLU<f8>, pg8::StaticOrder, true, true, true>(F.lds + RING_OFF, g8, S, E);
            } else {
            pg8::EpiSwiGLU<f8> E{(unsigned char*)ACT, STATX, (LAS float*)(F.lds + pg8::RS_TAB_OFF), 1.0f};
            pg8::gemm_phase<pg8::EpiSwiGLU<f8>, pg8::StaticOrder, true, true>(F.lds + RING_OFF, g, S, E);
            }
            SEAM(pb + L_GU2);
        }
        if (IN(pb + L_D2)) { PHASE_PTRS;
            constexpr bool f8 = d_is_f8(l, 1); constexpr int KD = f8 ? FF / 2 : FF;
            pg8::Gemm g{ACT, (const bf16_t*)(wl + W_D2), M, DM, KD, KD}; pg8::StaticOrder S; S.SINIT(M, DM, F.G, opaque_bx());
            pg8::EpiResid E{XB, STATX, f8 ? 0.5f / (ACT_F8_SCALE * WD_F8_SCALE) : 0.5f, (l + 1 < DEPTH && gu_is_f8(l + 1 < DEPTH ? l + 1 : l, 0)) ? (unsigned char*)xout : nullptr};
            pg8::gemm_phase<pg8::EpiResid, pg8::StaticOrder, true, true, f8>(F.lds + RING_OFF, g, S, E);
            SEAM(pb + L_D2);
        }
}
__global__ void __launch_bounds__(NWAVES * 64, 2) fwd_kernel(Args args) {
    extern __shared__ __attribute__((aligned(16))) unsigned char lds[];
    Frame F;
    F.lds = (LAS unsigned char*)lds;
    F.MISC = (volatile LAS unsigned*)(F.lds + MISC_OFF);
    F.wave = __builtin_amdgcn_readfirstlane((int)threadIdx.x >> 6);
    F.G = gridDim.x; { const int bx = blockIdx.x; F.vcu = (F.G % 8 == 0) ? (bx % 8) * (F.G / 8) + bx / 8 : bx; }
    F.ws = args.ws; F.ctl = (gu32*)(args.ws + WS_CTL);
    for (int u = threadIdx.x; u < (LDS_BYTES - LDSCTL_OFF) / 4; u += NWAVES * 64) ((LAS unsigned*)(F.lds + LDSCTL_OFF))[u] = 0u;
    __syncthreads();
    XcdBarrier bar; bar.bar = (unsigned*)(F.ctl + CW_BAR); bar.x = 0; bar.st = nullptr;
    if (args.ph_hi - args.ph_lo > 1) bar = xcd_barrier_post((unsigned*)(F.ctl + CW_BAR), F.MISC + 8);
    const int lo = args.ph_lo, hi = args.ph_hi;

    if (IN(PH_PRO)) { for (int rep = 0; rep < NREP(100); ++rep) { p0_prologue(F, args.in); __syncthreads(); } SEAM(PH_PRO); }

    static_assert(DEPTH == 2, "layer instantiations");
    layer_body<0>(F, args, bar, lo, hi);
    layer_body<1>(F, args, bar, lo, hi);
    if (IN(PH_FNORM)) final_norm(F, args.out, args.in.p[17]);
#undef IN
#undef SEAM
}

extern "C" void kernel_launch(void* const* d_in, const int* in_sizes, int n_in, void* d_out, int out_size, void* d_ws, size_t ws_size, hipStream_t stream) {
    static int grid = 0;
    if (grid == 0) {
        if (n_in != 18 || in_sizes[0] != M * DM || out_size != M * DM || ws_size < WS_END) { fprintf(stderr, "kernel_launch: unexpected shapes / workspace (n_in %d, ws %zu, need %zu); nothing launched\n", n_in, ws_size, (size_t)WS_END); grid = -1; return; }
        int dev = 0, cus = 0, per_cu = 0;
        if (hipGetDevice(&dev) != hipSuccess || hipDeviceGetAttribute(&cus, hipDeviceAttributeMultiprocessorCount, dev) != hipSuccess) { grid = -1; return; }
        if (hipFuncSetAttribute((const void*)fwd_kernel, hipFuncAttributeMaxDynamicSharedMemorySize, LDS_BYTES) != hipSuccess) { fprintf(stderr, "kernel_launch: hipFuncSetAttribute failed\n"); grid = -1; return; }
        if (hipOccupancyMaxActiveBlocksPerMultiprocessor(&per_cu, (const void*)fwd_kernel, NWAVES * 64, LDS_BYTES) != hipSuccess || per_cu < 1) { fprintf(stderr, "kernel_launch: occupancy query says %d blocks per CU\n", per_cu); }
        (void)hipGetLastError();
        grid = cus;
    }
    if (grid < 0) return;
    if (hipMemsetAsync((char*)d_ws + WS_CTL, 0, CTL_ZERO_BYTES, stream) != hipSuccess) return;
    Args a{};
    for (int i = 0; i < 18; ++i) a.in.p[i] = (const float*)d_in[i];
    a.out = (float*)d_out; a.ws = (unsigned char*)d_ws;
#if MK_ONE_LAUNCH
    a.ph_lo = 0; a.ph_hi = NPH;
    hipLaunchKernelGGL(fwd_kernel, dim3(grid), dim3(NWAVES * 64), LDS_BYTES, stream, a);
#else
    for (int ph = 0; ph < NPH; ++ph) {
        a.ph_lo = ph; a.ph_hi = ph + 1;
        hipLaunchKernelGGL(fwd_kernel, dim3(grid), dim3(NWAVES * 64), LDS_BYTES, stream, a);
    }
#endif
}
```
